# Optimizing an MI355X kernel written in HIP

```python
import jax, jax.numpy as jnp
from jax import lax
import numpy as np

D_MODEL = 2048
BATCH = 8
SEQ = 2048
DEPTH = 2

HEAD_DIM = 128
QBLOCK = 128
GRID_W = 64
EPS = 1e-6
NEG_INF = -1e30

MLA_HEADS = 8
MLA_Q_RANK = 512
MLA_KV_RANK = 256
MLA_NOPE = 128
MLA_ROPE = 64
MLA_V = 128
MLA_ROPE_THETA = 10000.0

GQA_HEADS = 8
GQA_KV_HEADS = 2
GQA_GROUP = GQA_HEADS // GQA_KV_HEADS
AXIAL_THETA = 10000.0

DIL_PATTERNS = ((128, 1), (512, 4), (2048, 16))
DIL_HEADS_PER_GROUP = 4
DIL_HEADS = DIL_HEADS_PER_GROUP * len(DIL_PATTERNS)
PARTIAL_ROPE_DIM = HEAD_DIM // 4
PARTIAL_ROPE_THETA = 500000.0

N_BRANCHES = 3
D_FF = 4 * D_MODEL

A_COLS = MLA_Q_RANK + MLA_KV_RANK + MLA_ROPE
B_COLS = (GQA_HEADS + 2 * GQA_KV_HEADS) * HEAD_DIM
C_COLS = 3 * DIL_HEADS * HEAD_DIM
GATE_COLS = N_BRANCHES * D_MODEL
IN_COLS = A_COLS + B_COLS + C_COLS + GATE_COLS

kernel_name = "hybrid_gated_mla_axialgqa_dilated_encoder"


def rms_norm(x, gain):
    xf = x.astype(jnp.float32)
    y = xf * lax.rsqrt(jnp.mean(xf * xf, axis=-1, keepdims=True) + EPS)
    return (y * gain.astype(jnp.float32)).astype(x.dtype)


def rotary(x, pos, theta):
    half = x.shape[-1] // 2
    inv = theta ** (-jnp.arange(half, dtype=jnp.float32) / half)
    ang = pos[:, None] * inv[None, :]
    cos = jnp.cos(ang)[:, None, :]
    sin = jnp.sin(ang)[:, None, :]
    xf = x.astype(jnp.float32)
    x1, x2 = xf[..., :half], xf[..., half:]
    return jnp.concatenate([x1 * cos - x2 * sin, x1 * sin + x2 * cos], axis=-1).astype(x.dtype)


def dense_block_attention(q, k, v):
    b, s, hkv, g, dk = q.shape
    scale = dk ** -0.5
    nb = s // QBLOCK
    qb = jnp.moveaxis(q.reshape(b, nb, QBLOCK, hkv, g, dk), 1, 0)

    def attend(qblk):
        sc = jnp.einsum('bqhgd,bkhd->bhgqk', qblk, k).astype(jnp.float32) * scale
        p = jax.nn.softmax(sc, axis=-1).astype(v.dtype)
        return jnp.einsum('bhgqk,bkhd->bqhgd', p, v)

    o = lax.map(attend, qb)
    return jnp.moveaxis(o, 0, 1).reshape(b, s, hkv * g, v.shape[-1])


def mla_mixer(xa, pos, q_lat_norm, w_uq, kv_lat_norm, w_ukv, q_head_norm, k_head_norm):
    b, s, _ = xa.shape
    c_q = xa[..., :MLA_Q_RANK]
    c_kv = xa[..., MLA_Q_RANK:MLA_Q_RANK + MLA_KV_RANK]
    k_pe = xa[..., MLA_Q_RANK + MLA_KV_RANK:]
    q = (rms_norm(c_q, q_lat_norm) @ w_uq).reshape(b, s, MLA_HEADS, MLA_NOPE + MLA_ROPE)
    kv = (rms_norm(c_kv, kv_lat_norm) @ w_ukv).reshape(b, s, MLA_HEADS, MLA_NOPE + MLA_V)
    k_nope, v = kv[..., :MLA_NOPE], kv[..., MLA_NOPE:]
    k = jnp.concatenate(
        [k_nope, jnp.broadcast_to(k_pe[:, :, None, :], (b, s, MLA_HEADS, MLA_ROPE))], axis=-1)
    q = rms_norm(q, q_head_norm)
    k = rms_norm(k, k_head_norm)
    q = jnp.concatenate([q[..., :MLA_NOPE], rotary(q[..., MLA_NOPE:], pos, MLA_ROPE_THETA)], axis=-1)
    k = jnp.concatenate([k[..., :MLA_NOPE], rotary(k[..., MLA_NOPE:], pos, MLA_ROPE_THETA)], axis=-1)
    o = dense_block_attention(q[:, :, :, None, :], k, v)
    return o.reshape(b, s, MLA_HEADS * MLA_V)


def axial_rotary(x, row, col):
    half = x.shape[-1] // 2
    return jnp.concatenate([rotary(x[..., :half], row, AXIAL_THETA),
                            rotary(x[..., half:], col, AXIAL_THETA)], axis=-1)


def gqa_mixer(xb, row, col, q_norm, k_norm):
    b, s, _ = xb.shape
    nq = GQA_HEADS * HEAD_DIM
    nk = GQA_KV_HEADS * HEAD_DIM
    q = xb[..., :nq].reshape(b, s, GQA_HEADS, HEAD_DIM)
    k = xb[..., nq:nq + nk].reshape(b, s, GQA_KV_HEADS, HEAD_DIM)
    v = xb[..., nq + nk:].reshape(b, s, GQA_KV_HEADS, HEAD_DIM)
    q = axial_rotary(rms_norm(q, q_norm), row, col)
    k = axial_rotary(rms_norm(k, k_norm), row, col)
    q = q.reshape(b, s, GQA_KV_HEADS, GQA_GROUP, HEAD_DIM)
    o = dense_block_attention(q, k, v)
    return o.reshape(b, s, GQA_HEADS * HEAD_DIM)


def dilated_window_attention(q, k, v, dilation, radius):
    b, s, h, d = q.shape
    scale = d ** -0.5
    L = s // dilation

    def strided(t):
        return t.reshape(b, L, dilation, h, d).transpose(0, 2, 1, 3, 4)

    qd, kd, vd = strided(q), strided(k), strided(v)
    nb = -(-L // QBLOCK)
    lq = nb * QBLOCK
    kb_len = QBLOCK + 2 * radius
    qp = jnp.pad(qd, ((0, 0), (0, 0), (0, lq - L), (0, 0), (0, 0)))
    pad_kv = ((0, 0), (0, 0), (radius, lq - L + radius), (0, 0), (0, 0))
    kp = jnp.pad(kd, pad_kv)
    vp = jnp.pad(vd, pad_kv)
    idx = jnp.arange(nb)[:, None] * QBLOCK + jnp.arange(kb_len)[None, :]
    kb = kp[:, :, idx]
    vb = vp[:, :, idx]
    qb = qp.reshape(b, dilation, nb, QBLOCK, h, d)
    sc = jnp.einsum('brnqhd,brnkhd->brnhqk', qb, kb).astype(jnp.float32) * scale
    rel = jnp.arange(kb_len)[None, :] - radius - jnp.arange(QBLOCK)[:, None]
    korig = idx - radius
    valid = (jnp.abs(rel) <= radius)[None] & ((korig >= 0) & (korig < L))[:, None, :]
    sc = jnp.where(valid[:, None], sc, NEG_INF)
    lse = jax.nn.logsumexp(sc, axis=-1)
    p = jnp.exp(sc - lse[..., None]).astype(v.dtype)
    o = jnp.einsum('brnhqk,brnkhd->brnqhd', p, vb)
    o = o.reshape(b, dilation, lq, h, d)[:, :, :L].transpose(0, 2, 1, 3, 4).reshape(b, s, h, d)
    lse = lse.transpose(0, 1, 2, 4, 3).reshape(b, dilation, lq, h)[:, :, :L]
    lse = lse.transpose(0, 2, 1, 3).reshape(b, s, h)
    return o, lse


def dilated_mixer(xc, pos, q_norm, k_norm):
    b, s, _ = xc.shape
    w = DIL_HEADS * HEAD_DIM
    q = xc[..., :w].reshape(b, s, DIL_HEADS, HEAD_DIM)
    k = xc[..., w:2 * w].reshape(b, s, DIL_HEADS, HEAD_DIM)
    v = xc[..., 2 * w:].reshape(b, s, DIL_HEADS, HEAD_DIM)
    q = rms_norm(q, q_norm)
    k = rms_norm(k, k_norm)
    q = jnp.concatenate([rotary(q[..., :PARTIAL_ROPE_DIM], pos, PARTIAL_ROPE_THETA),
                         q[..., PARTIAL_ROPE_DIM:]], axis=-1)
    k = jnp.concatenate([rotary(k[..., :PARTIAL_ROPE_DIM], pos, PARTIAL_ROPE_THETA),
                         k[..., PARTIAL_ROPE_DIM:]], axis=-1)
    outs, lses = [], []
    for gi, (window, dilation) in enumerate(DIL_PATTERNS):
        hs = slice(gi * DIL_HEADS_PER_GROUP, (gi + 1) * DIL_HEADS_PER_GROUP)
        o, lse = dilated_window_attention(q[:, :, hs], k[:, :, hs], v[:, :, hs],
                                          dilation, window // (2 * dilation))
        outs.append(o)
        lses.append(lse)
    wts = jax.nn.softmax(jnp.stack(lses, axis=0), axis=0)
    o = jnp.sum(wts[..., None] * jnp.stack(outs, axis=0).astype(jnp.float32), axis=0)
    return o.astype(xc.dtype).reshape(b, s, DIL_HEADS_PER_GROUP * HEAD_DIM)


def _normal(key, shape, scale):
    return scale * jax.random.normal(key, shape, jnp.float32)


def _gain(key, shape):
    return 1.0 + 0.05 * jax.random.normal(key, shape, jnp.float32)


def setup_inputs(seed: int = 0) -> dict:
    key = jax.random.key(seed)
    ks = jax.random.split(key, 24)
    return {
        "x": _normal(ks[0], (BATCH, SEQ, D_MODEL), 1.0),
        "attn_norm": _gain(ks[1], (DEPTH, D_MODEL)),
        "w_in": _normal(ks[2], (DEPTH, D_MODEL, IN_COLS), D_MODEL ** -0.5),
        "b_gate": _normal(ks[3], (DEPTH, GATE_COLS), 0.01),
        "mla_q_lat_norm": _gain(ks[4], (DEPTH, MLA_Q_RANK)),
        "w_uq": _normal(ks[5], (DEPTH, MLA_Q_RANK, MLA_HEADS * (MLA_NOPE + MLA_ROPE)), MLA_Q_RANK ** -0.5),
        "mla_kv_lat_norm": _gain(ks[6], (DEPTH, MLA_KV_RANK)),
        "w_ukv": _normal(ks[7], (DEPTH, MLA_KV_RANK, MLA_HEADS * (MLA_NOPE + MLA_V)), MLA_KV_RANK ** -0.5),
        "mla_q_head_norm": _gain(ks[8], (DEPTH, MLA_NOPE + MLA_ROPE)),
        "mla_k_head_norm": _gain(ks[9], (DEPTH, MLA_NOPE + MLA_ROPE)),
        "gqa_q_norm": _gain(ks[10], (DEPTH, HEAD_DIM)),
        "gqa_k_norm": _gain(ks[11], (DEPTH, HEAD_DIM)),
        "dil_q_norm": _gain(ks[12], (DEPTH, HEAD_DIM)),
        "dil_k_norm": _gain(ks[13], (DEPTH, HEAD_DIM)),
        "w_oa": _normal(ks[14], (DEPTH, MLA_HEADS * MLA_V, D_MODEL), (MLA_HEADS * MLA_V) ** -0.5),
        "w_ob": _normal(ks[15], (DEPTH, GQA_HEADS * HEAD_DIM, D_MODEL), (GQA_HEADS * HEAD_DIM) ** -0.5),
        "w_oc": _normal(ks[16], (DEPTH, DIL_HEADS_PER_GROUP * HEAD_DIM, D_MODEL),
                        (DIL_HEADS_PER_GROUP * HEAD_DIM) ** -0.5),
        "w_out": _normal(ks[17], (DEPTH, D_MODEL, D_MODEL), D_MODEL ** -0.5),
        "mlp_norm": _gain(ks[18], (DEPTH, D_MODEL)),
        "w_up": _normal(ks[19], (DEPTH, D_MODEL, D_FF), D_MODEL ** -0.5),
        "w_down": _normal(ks[20], (DEPTH, D_FF, D_MODEL), D_FF ** -0.5),
    }


def reference(x, attn_norm, w_in, b_gate, mla_q_lat_norm, w_uq, mla_kv_lat_norm, w_ukv,
              mla_q_head_norm, mla_k_head_norm, gqa_q_norm, gqa_k_norm, dil_q_norm, dil_k_norm,
              w_oa, w_ob, w_oc, w_out, mlp_norm, w_up, w_down):
    b, s, _ = x.shape
    rows = s // GRID_W
    pos = jnp.arange(s, dtype=jnp.float32)
    row = jnp.repeat(jnp.arange(rows, dtype=jnp.float32), GRID_W)
    col = jnp.tile(jnp.arange(GRID_W, dtype=jnp.float32), rows)
    for l in range(DEPTH):
        xn = rms_norm(x, attn_norm[l])
        proj = xn @ w_in[l]
        xa = proj[..., :A_COLS]
        xb = proj[..., A_COLS:A_COLS + B_COLS]
        xc = proj[..., A_COLS + B_COLS:A_COLS + B_COLS + C_COLS]
        gl = proj[..., A_COLS + B_COLS + C_COLS:] + b_gate[l]
        ya = mla_mixer(xa, pos, mla_q_lat_norm[l], w_uq[l], mla_kv_lat_norm[l], w_ukv[l],
                       mla_q_head_norm[l], mla_k_head_norm[l]) @ w_oa[l]
        yb = gqa_mixer(xb, row, col, gqa_q_norm[l], gqa_k_norm[l]) @ w_ob[l]
        yc = dilated_mixer(xc, pos, dil_q_norm[l], dil_k_norm[l]) @ w_oc[l]
        gates = jax.nn.sigmoid(gl.astype(jnp.float32)).astype(x.dtype).reshape(b, s, N_BRANCHES, D_MODEL)
        merged = gates[:, :, 0] * ya + gates[:, :, 1] * yb + gates[:, :, 2] * yc
        x = x + merged @ w_out[l]
        hn = rms_norm(x, mlp_norm[l])
        x = x + jnp.square(jax.nn.relu(hn @ w_up[l])) @ w_down[l]
    return x
```

```cpp
#define ATT_PIPE128 1
#define ATT_PVHALF 1
#include <hip/hip_runtime.h>
#include <hip/hip_cooperative_groups.h>
#include <cstdio>
#include <cstdint>
namespace cg = cooperative_groups;
namespace pg8 {
#define PG8_LAS __attribute__((address_space(3)))
typedef unsigned short bf16_t;
typedef short bf16x8 __attribute__((ext_vector_type(8)));
typedef float f32x4 __attribute__((ext_vector_type(4)));
typedef unsigned u32x4 __attribute__((ext_vector_type(4)));
constexpr int BM = 256, BK = 64, HALF = 128, HTB = HALF * BK * 2  , STAGE_BYTES = 8 * HTB, NXCD = 8, WGM = 8;

__host__ __device__ __forceinline__ int lds_byte(int r, int c) { const int st = (r >> 4) * 2 + (c >> 5), rr = r & 15, cc = c & 31, ob = rr * 64 + cc * 2; return st * 1024 + (ob ^ (((ob >> 9) & 1) << 5)); }
__host__ __device__ __forceinline__ void stage_rc(int b, int& R, int& C) { const int st = b / 1024, sb = b % 1024, swz = sb ^ (((sb >> 9) & 1) << 5); R = (st >> 1) * 16 + swz / 64; C = (st & 1) * 32 + (swz % 64) / 2; }
__host__ __device__ __forceinline__ int perm32(int rho) { const int n = rho >> 4, i = rho & 15; return 8 * (i >> 2) + 4 * n + (i & 3); }

struct Unit { int pm, pn; };
struct Gemm { const bf16_t* A; const bf16_t* Bt; int M, N, K; };

struct StaticOrder {
    int nM, nN, nwg, G, c;
    __host__ __device__ void init(int M, int N, int G_, int c_) { nM = M / BM; nN = N / BM; nwg = nM * nN; G = G_; c = c_; }
    __host__ __device__ bool next(int i, Unit& u) const {
        const long L = (long)i * G + c; if (L >= nwg) return false;
        int wgid = (int)L; { const int q = nwg / NXCD, r = nwg % NXCD, xcd = wgid % NXCD, off = wgid / NXCD; wgid = (xcd < r ? xcd * (q + 1) : r * (q + 1) + (xcd - r) * q) + off; }
        const int nig = WGM * nN, gid = wgid / nig, fm = gid * WGM, gsz = (nM - fm) < WGM ? (nM - fm) : WGM;
        u.pm = fm + ((wgid % nig) % gsz); u.pn = (wgid % nig) / gsz; return true;
    }
    __device__ __forceinline__ void a_ready(const Unit&) const {}
    __device__ __forceinline__ void done(const Unit&) const {}
};
typedef float f32x2_cv __attribute__((ext_vector_type(2)));
typedef __bf16 bf16x2_cv __attribute__((ext_vector_type(2)));
__device__ __forceinline__ unsigned cvt_pk_bf16(float lo, float hi) { const f32x2_cv v = {lo, hi}; const bf16x2_cv b = __builtin_convertvector(v, bf16x2_cv); return __builtin_bit_cast(unsigned, b); }
typedef unsigned u32x4 __attribute__((ext_vector_type(4)));
typedef unsigned u32x2 __attribute__((ext_vector_type(2)));
template <int ACT  > struct EpiBf16 {
    static constexpr bool PERM = true, AFTER_DRAIN = false;
    bf16_t* O; int ldc;
    __device__ __forceinline__ void operator()(const f32x4 (&acc)[2][2][4][2], const Unit& u, int wr, int wc, int fr, int fq) const {
        const int row0 = u.pm * BM + wr * 64 + fr, col0 = u.pn * BM + wc * 32 + 8 * fq;
#pragma unroll
        for (int ai = 0; ai < 2; ++ai)
#pragma unroll
            for (int m = 0; m < 4; ++m) { bf16_t* rowp = O + (size_t)(row0 + ai * HALF + m * 16) * ldc + col0;
#pragma unroll
                for (int bj = 0; bj < 2; ++bj) { f32x4 v0 = acc[ai][bj][m][0], v1 = acc[ai][bj][m][1];
                    if (ACT == 1) {
#pragma unroll
                        for (int e = 0; e < 4; ++e) { float a = fmaxf(v0[e], 0.f), b = fmaxf(v1[e], 0.f); v0[e] = a * a; v1[e] = b * b; } }
                    u32x4 w; w.x = cvt_pk_bf16(v0[0], v0[1]); w.y = cvt_pk_bf16(v0[2], v0[3]); w.z = cvt_pk_bf16(v1[0], v1[1]); w.w = cvt_pk_bf16(v1[2], v1[3]);
                    *(u32x4*)(rowp + bj * HALF) = w; } }
    }
};
struct EpiF32 {
    static constexpr bool PERM = false, AFTER_DRAIN = false;
    float* out; int ldc;
    __device__ __forceinline__ void operator()(const f32x4 (&acc)[2][2][4][2], const Unit& u, int wr, int wc, int fr, int fq) const {
        const int row0 = u.pm * BM + wr * 64 + fr, col0 = u.pn * BM + wc * 32 + 4 * fq;
#pragma unroll
        for (int ai = 0; ai < 2; ++ai)
#pragma unroll
            for (int m = 0; m < 4; ++m) { const size_t off = (size_t)(row0 + ai * HALF + m * 16) * ldc + col0;
#pragma unroll
                for (int bj = 0; bj < 2; ++bj)
#pragma unroll
                    for (int n = 0; n < 2; ++n) *(f32x4*)(out + off + bj * HALF + n * 16) = acc[ai][bj][m][n]; }
    }
};
struct EpiResid {
    static constexpr bool PERM = false, AFTER_DRAIN = false;
    const float* base; float* out; int ldc;
    __device__ __forceinline__ void operator()(const f32x4 (&acc)[2][2][4][2], const Unit& u, int wr, int wc, int fr, int fq) const {
        const int row0 = u.pm * BM + wr * 64 + fr, col0 = u.pn * BM + wc * 32 + 4 * fq;
        f32x4 bA[8], bB[8];
#define EPI_LD(dst, g) _Pragma("unroll") for (int q = 0; q < 8; ++q) { const int ai = (g) >> 1, m = ((g) & 1) * 2 + (q >> 2), bj = (q >> 1) & 1, n = q & 1; \
        dst[q] = *(const f32x4*)(base + (size_t)(row0 + ai * HALF + m * 16) * ldc + col0 + bj * HALF + n * 16); }
#define EPI_ST(src, g) _Pragma("unroll") for (int q = 0; q < 8; ++q) { const int ai = (g) >> 1, m = ((g) & 1) * 2 + (q >> 2), bj = (q >> 1) & 1, n = q & 1; \
        *(f32x4*)(out + (size_t)(row0 + ai * HALF + m * 16) * ldc + col0 + bj * HALF + n * 16) = acc[ai][bj][m][n] + src[q]; }
        EPI_LD(bA, 0); EPI_LD(bB, 1); EPI_ST(bA, 0); EPI_LD(bA, 2); EPI_ST(bB, 1); EPI_LD(bB, 3); EPI_ST(bA, 2); EPI_ST(bB, 3);
#undef EPI_LD
#undef EPI_ST
    }
};
struct EpiProj {
    static constexpr bool PERM = true, AFTER_DRAIN = false; static constexpr int VMOPS = 16;
    bf16_t* F; int ldf; int ntf; bf16_t* O; int ldc;
    __device__ __forceinline__ void operator()(const f32x4 (&acc)[2][2][4][2], const Unit& u, int wr, int wc, int fr, int fq) const {
        const int row0 = u.pm * BM + wr * 64 + fr; const bool lat = u.pn < ntf;
        bf16_t* base = lat ? F : O; const int ld = lat ? ldf : ldc; const int col0 = (lat ? u.pn : u.pn - ntf) * BM + wc * 32 + 8 * fq;
#pragma unroll
        for (int ai = 0; ai < 2; ++ai)
#pragma unroll
            for (int m = 0; m < 4; ++m) { bf16_t* rowp = base + (size_t)(row0 + ai * HALF + m * 16) * ld + col0;
#pragma unroll
                for (int bj = 0; bj < 2; ++bj) { const f32x4 v0 = acc[ai][bj][m][0], v1 = acc[ai][bj][m][1];
                    u32x4 w; w.x = cvt_pk_bf16(v0[0], v0[1]); w.y = cvt_pk_bf16(v0[2], v0[3]); w.z = cvt_pk_bf16(v1[0], v1[1]); w.w = cvt_pk_bf16(v1[2], v1[3]);
                    *(u32x4*)(rowp + bj * HALF) = w; } }
    }
};
template <bool TO_F32> struct EpiResidB {
    static constexpr bool PERM = true, AFTER_DRAIN = false; static constexpr int VMOPS = 32;
    const bf16_t* base; bf16_t* outb; float* outf; int ldc;
    __device__ __forceinline__ void operator()(const f32x4 (&acc)[2][2][4][2], const Unit& u, int wr, int wc, int fr, int fq) const {
        const int row0 = u.pm * BM + wr * 64 + fr, col0 = u.pn * BM + wc * 32 + 8 * fq;
        u32x4 bA[4], bB[4];
#define EPI_LD(dst, g) _Pragma("unroll") for (int q = 0; q < 4; ++q) { const int ai = (g) >> 1, m = ((g) & 1) * 2 + (q >> 1), bj = q & 1; \
        dst[q] = *(const u32x4*)(base + (size_t)(row0 + ai * HALF + m * 16) * ldc + col0 + bj * HALF); }
#define EPI_ST(src, g) _Pragma("unroll") for (int q = 0; q < 4; ++q) { const int ai = (g) >> 1, m = ((g) & 1) * 2 + (q >> 1), bj = q & 1; \
        const size_t off = (size_t)(row0 + ai * HALF + m * 16) * ldc + col0 + bj * HALF; const u32x4 b = src[q]; f32x4 v0 = acc[ai][bj][m][0], v1 = acc[ai][bj][m][1]; \
        v0[0] += __uint_as_float(b.x << 16); v0[1] += __uint_as_float(b.x & 0xffff0000u); v0[2] += __uint_as_float(b.y << 16); v0[3] += __uint_as_float(b.y & 0xffff0000u); \
        v1[0] += __uint_as_float(b.z << 16); v1[1] += __uint_as_float(b.z & 0xffff0000u); v1[2] += __uint_as_float(b.w << 16); v1[3] += __uint_as_float(b.w & 0xffff0000u); \
        if constexpr (TO_F32) { *(f32x4*)(outf + off) = v0; *(f32x4*)(outf + off + 4) = v1; } \
        else { u32x4 w; w.x = cvt_pk_bf16(v0[0], v0[1]); w.y = cvt_pk_bf16(v0[2], v0[3]); w.z = cvt_pk_bf16(v1[0], v1[1]); w.w = cvt_pk_bf16(v1[2], v1[3]); *(u32x4*)(outb + off) = w; } }
        EPI_LD(bA, 0); EPI_LD(bB, 1); EPI_ST(bA, 0); EPI_LD(bA, 2); EPI_ST(bB, 1); EPI_LD(bB, 3); EPI_ST(bA, 2); EPI_ST(bB, 3);
#undef EPI_LD
#undef EPI_ST
    }
};
__device__ __forceinline__ float bf_lo(unsigned w) { return __uint_as_float(w << 16); }
__device__ __forceinline__ float bf_hi(unsigned w) { return __uint_as_float(w & 0xffff0000u); }
struct EpiSig {
    static constexpr bool PERM = true, AFTER_DRAIN = false;
    u32x4* S; const float* bias; int nN;
    __device__ __forceinline__ void operator()(const f32x4 (&acc)[2][2][4][2], const Unit& u, int wr, int wc, int fr, int fq) const {
        u32x4* sp = S + (size_t)(u.pm * nN + u.pn) * (16 * 512) + (wr * 4 + wc) * 64 + fq * 16 + fr;
        const int col0 = u.pn * BM + wc * 32 + 8 * fq;
#pragma unroll
        for (int bj = 0; bj < 2; ++bj) { const f32x4 b0 = *(const f32x4*)(bias + col0 + bj * HALF), b1 = *(const f32x4*)(bias + col0 + bj * HALF + 4);
#pragma unroll
            for (int ai = 0; ai < 2; ++ai)
#pragma unroll
                for (int m = 0; m < 4; ++m) { f32x4 v0 = acc[ai][bj][m][0] + b0, v1 = acc[ai][bj][m][1] + b1;
#pragma unroll
                    for (int e = 0; e < 4; ++e) { v0[e] = __builtin_amdgcn_rcpf(1.f + __expf(-v0[e])); v1[e] = __builtin_amdgcn_rcpf(1.f + __expf(-v1[e])); }
                    u32x4 w; w.x = cvt_pk_bf16(v0[0], v0[1]); w.y = cvt_pk_bf16(v0[2], v0[3]); w.z = cvt_pk_bf16(v1[0], v1[1]); w.w = cvt_pk_bf16(v1[2], v1[3]);
                    sp[((ai * 2 + bj) * 4 + m) * 512] = w; } }
    }
};
struct EpiGate {
    static constexpr bool PERM = true, AFTER_DRAIN = false;
    const u32x4* S; u32x4* Mt; bf16_t* O; int ldc; int nN; int mode;
    template <int MODE>
    __device__ __forceinline__ void body(const f32x4 (&acc)[2][2][4][2], const Unit& u, int wr, int wc, int fr, int fq) const {
        const size_t sb = (size_t)(u.pm * nN + u.pn) * (16 * 512) + (wr * 4 + wc) * 64 + fq * 16 + fr;
        const int row0 = u.pm * BM + wr * 64 + fr, col0 = u.pn * BM + wc * 32 + 8 * fq;
        u32x4 sA[2], mA[2], sB[2], mB[2];
#define EPI_LD(sd, md, g) _Pragma("unroll") for (int q = 0; q < 2; ++q) { sd[q] = S[sb + ((g) * 2 + q) * 512]; if constexpr (MODE != 0) md[q] = Mt[sb + ((g) * 2 + q) * 512]; else md[q] = (u32x4){0u, 0u, 0u, 0u}; }
#define EPI_ST(sd, md, g) _Pragma("unroll") for (int q = 0; q < 2; ++q) { const int ai = (g) >> 2, bj = ((g) >> 1) & 1, m = 2 * ((g) & 1) + q; const u32x4 sw = sd[q], ow = md[q]; \
            const f32x4 a0 = acc[ai][bj][m][0], a1 = acc[ai][bj][m][1]; \
            const float v0 = bf_lo(sw.x) * a0[0] + bf_lo(ow.x), v1 = bf_hi(sw.x) * a0[1] + bf_hi(ow.x), v2 = bf_lo(sw.y) * a0[2] + bf_lo(ow.y), v3 = bf_hi(sw.y) * a0[3] + bf_hi(ow.y), \
                        v4 = bf_lo(sw.z) * a1[0] + bf_lo(ow.z), v5 = bf_hi(sw.z) * a1[1] + bf_hi(ow.z), v6 = bf_lo(sw.w) * a1[2] + bf_lo(ow.w), v7 = bf_hi(sw.w) * a1[3] + bf_hi(ow.w); \
            u32x4 w; w.x = cvt_pk_bf16(v0, v1); w.y = cvt_pk_bf16(v2, v3); w.z = cvt_pk_bf16(v4, v5); w.w = cvt_pk_bf16(v6, v7); \
            if constexpr (MODE != 2) Mt[sb + ((g) * 2 + q) * 512] = w; else *(u32x4*)(O + (size_t)(row0 + ai * HALF + m * 16) * ldc + col0 + bj * HALF) = w; }
        EPI_LD(sA, mA, 0); EPI_LD(sB, mB, 1); EPI_ST(sA, mA, 0); EPI_LD(sA, mA, 2); EPI_ST(sB, mB, 1); EPI_LD(sB, mB, 3); EPI_ST(sA, mA, 2); EPI_LD(sA, mA, 4); EPI_ST(sB, mB, 3);
        EPI_LD(sB, mB, 5); EPI_ST(sA, mA, 4); EPI_LD(sA, mA, 6); EPI_ST(sB, mB, 5); EPI_LD(sB, mB, 7); EPI_ST(sA, mA, 6); EPI_ST(sB, mB, 7);
#undef EPI_LD
#undef EPI_ST
    }
    __device__ __forceinline__ void operator()(const f32x4 (&acc)[2][2][4][2], const Unit& u, int wr, int wc, int fr, int fq) const {
        if (mode == 0) body<0>(acc, u, wr, wc, fr, fq); else if (mode == 1) body<1>(acc, u, wr, wc, fr, fq); else body<2>(acc, u, wr, wc, fr, fq);
    }
};
template <class Epi, class Sched, bool ALIGN_EPI = false, bool SP2 = false>
__device__ __forceinline__ void gemm_phase(PG8_LAS unsigned char* lds, const Gemm g, const Sched& S, const Epi& E) {
    int tid_ = threadIdx.x; asm volatile("" : "+v"(tid_));
    const int tid = tid_, wid = __builtin_amdgcn_readfirstlane(tid >> 6), lane = tid & 63, wr = wid >> 2, wc = wid & 3, fr = lane & 15, fq = lane >> 4;
    const int K = g.K, nt = K / BK;
    unsigned voffA[2], voffB[2];
#pragma unroll
    for (int i = 0; i < 2; ++i) { int R, C; stage_rc(tid * 16 + i * 8192, R, C); const int Rb = Epi::PERM ? ((R & ~31) + perm32(R & 31)) : R;
        voffA[i] = (unsigned)(R * K + C) * 2u; voffB[i] = (unsigned)(Rb * K + C) * 2u; }
    const size_t kstep = (size_t)(BK * 2);
    const size_t hstep = (size_t)HALF * K * 2;
    const size_t tstep = 2 * hstep;
    const unsigned ldsw = (unsigned)wid * 1024u;
    const int aoff = lds_byte(wr * 64 + fr, fq * 8), boff = lds_byte(wc * 32 + fr, fq * 8);
#define PG8_SA(b, h) (((b) * 2 + (h)) * HTB)
#define PG8_SB(b, h) ((4 + (b) * 2 + (h)) * HTB)
#define PG8_STAGE(bufoff, gbase, voff) do { _Pragma("unroll") for (int _i = 0; _i < 2; ++_i) \
        __builtin_amdgcn_global_load_lds((const unsigned*)((const char*)(gbase) + (voff)[_i]), (PG8_LAS unsigned*)(lds + (bufoff) + ldsw + _i * 8192), 16, 0, 0); } while (0)
#define PG8_LDA(dst, b, h) do { _Pragma("unroll") for (int m = 0; m < 4; ++m) _Pragma("unroll") for (int k = 0; k < 2; ++k) dst[m][k] = *(const PG8_LAS bf16x8*)(lds + PG8_SA(b, h) + aoff + m * 2048 + k * 1024); } while (0)
#define PG8_LDB(dst, b, h) do { _Pragma("unroll") for (int n = 0; n < 2; ++n) _Pragma("unroll") for (int k = 0; k < 2; ++k) dst[n][k] = *(const PG8_LAS bf16x8*)(lds + PG8_SB(b, h) + boff + n * 2048 + k * 1024); } while (0)
#define PG8_MMA(ai, bj, At, Bt) do { __builtin_amdgcn_s_setprio(1); _Pragma("unroll") for (int m = 0; m < 4; ++m) _Pragma("unroll") for (int n = 0; n < 2; ++n) _Pragma("unroll") for (int k = 0; k < 2; ++k) \
        acc[ai][bj][m][n] = __builtin_amdgcn_mfma_f32_16x16x32_bf16(Bt[n][k], At[m][k], acc[ai][bj][m][n], 0, 0, 0); __builtin_amdgcn_s_setprio(0); } while (0)
#define PG8_WAIT_V(n) asm volatile("s_waitcnt vmcnt(" #n ")" ::: "memory")
#define PG8_WAIT_L(n) asm volatile("s_waitcnt lgkmcnt(" #n ")" ::: "memory")
#define PG8_BAR __builtin_amdgcn_s_barrier()
#define PG8_SCHED __builtin_amdgcn_sched_barrier(0)
    Unit cur, nxt; int ui = 0;
    if (!S.next(0, cur)) return;
    f32x4 acc[2][2][4][2];
#pragma unroll
    for (int a = 0; a < 2; ++a)
#pragma unroll
        for (int b = 0; b < 2; ++b)
#pragma unroll
            for (int m = 0; m < 4; ++m)
#pragma unroll
                for (int n = 0; n < 2; ++n) acc[a][b][m][n] = (f32x4){0.f, 0.f, 0.f, 0.f};
    bf16x8 At[4][2], B0[2][2], B1[2][2];
    const char* cA = (const char*)g.A + (size_t)cur.pm * tstep; const char* cB = (const char*)g.Bt + (size_t)cur.pn * tstep;
    S.a_ready(cur);
    if constexpr (SP2) {
        PG8_STAGE(PG8_SB(0, 0), cB, voffB); PG8_STAGE(PG8_SB(0, 1), cB + hstep, voffB); PG8_STAGE(PG8_SA(0, 0), cA, voffA); PG8_STAGE(PG8_SA(0, 1), cA + hstep, voffA);
        if (wr == 1) PG8_BAR;
        PG8_WAIT_V(2); PG8_BAR;
        PG8_STAGE(PG8_SB(1, 0), cB + kstep, voffB); PG8_STAGE(PG8_SA(1, 0), cA + kstep, voffA); PG8_STAGE(PG8_SB(1, 1), cB + hstep + kstep, voffB);
        PG8_WAIT_V(6); PG8_BAR;
    } else {
        PG8_STAGE(PG8_SB(0, 0), cB, voffB); PG8_STAGE(PG8_SA(0, 0), cA, voffA); PG8_STAGE(PG8_SB(0, 1), cB + hstep, voffB); PG8_STAGE(PG8_SA(0, 1), cA + hstep, voffA);
        if (wr == 1) PG8_BAR;
        PG8_WAIT_V(4); PG8_BAR;
        PG8_STAGE(PG8_SB(1, 0), cB + kstep, voffB); PG8_STAGE(PG8_SA(1, 0), cA + kstep, voffA); PG8_STAGE(PG8_SB(1, 1), cB + hstep + kstep, voffB);
        PG8_WAIT_V(6); PG8_BAR;
    }
    for (;;) {
        const bool has_next = S.next(ui + 1, nxt);
        const char* nA = has_next ? (const char*)g.A + (size_t)nxt.pm * tstep : cA; const char* nB = has_next ? (const char*)g.Bt + (size_t)nxt.pn * tstep : cB;
        for (int t = 0; t < nt; t += 2) {
            const bool last = (t == nt - 2);
            const char* a1 = cA + (size_t)(t + 1) * kstep;
            const char* a2 = last ? nA : cA + (size_t)(t + 2) * kstep; const char* b2 = last ? nB : cB + (size_t)(t + 2) * kstep;
            const char* a3 = a2 + kstep; const char* b3 = b2 + kstep;
            if (last && has_next) S.a_ready(nxt);
            if constexpr (SP2) {
            PG8_LDB(B0, 0, 0); PG8_LDB(B1, 0, 1); PG8_SCHED; PG8_LDA(At, 0, 0); PG8_STAGE(PG8_SA(1, 1), a1 + hstep, voffA);
            PG8_WAIT_V(8); PG8_WAIT_L(0); PG8_BAR; PG8_MMA(0, 0, At, B0); PG8_MMA(0, 1, At, B1); PG8_BAR; PG8_SCHED;
            PG8_LDA(At, 0, 1); PG8_STAGE(PG8_SB(0, 0), b2, voffB); PG8_STAGE(PG8_SB(0, 1), b2 + hstep, voffB); PG8_STAGE(PG8_SA(0, 0), a2, voffA);
            PG8_WAIT_V(8); PG8_WAIT_L(0); PG8_BAR; PG8_MMA(1, 0, At, B0); PG8_MMA(1, 1, At, B1); PG8_BAR; PG8_SCHED;
            PG8_LDB(B0, 1, 0); PG8_LDB(B1, 1, 1); PG8_SCHED; PG8_LDA(At, 1, 0); PG8_STAGE(PG8_SA(0, 1), a2 + hstep, voffA);
            PG8_WAIT_V(8); PG8_WAIT_L(0); PG8_BAR; PG8_MMA(0, 0, At, B0); PG8_MMA(0, 1, At, B1); PG8_BAR; PG8_SCHED;
            PG8_LDA(At, 1, 1); PG8_STAGE(PG8_SB(1, 0), b3, voffB); PG8_STAGE(PG8_SB(1, 1), b3 + hstep, voffB); PG8_STAGE(PG8_SA(1, 0), a3, voffA);
            PG8_WAIT_V(8); PG8_WAIT_L(0); PG8_BAR; PG8_MMA(1, 0, At, B0); PG8_MMA(1, 1, At, B1); PG8_BAR; PG8_SCHED;
            } else {
            PG8_LDB(B0, 0, 0); PG8_SCHED; PG8_LDA(At, 0, 0); PG8_STAGE(PG8_SA(1, 1), a1 + hstep, voffA);
            PG8_WAIT_L(8); PG8_BAR; PG8_WAIT_L(0); PG8_MMA(0, 0, At, B0); PG8_BAR; PG8_SCHED;
            PG8_LDB(B1, 0, 1); PG8_STAGE(PG8_SB(0, 0), b2, voffB);
            PG8_BAR; PG8_WAIT_L(0); PG8_MMA(0, 1, At, B1); PG8_BAR;
            PG8_LDA(At, 0, 1); PG8_STAGE(PG8_SA(0, 0), a2, voffA);
            PG8_BAR; PG8_WAIT_L(0); PG8_MMA(1, 0, At, B0); PG8_BAR; PG8_SCHED;
            PG8_STAGE(PG8_SB(0, 1), b2 + hstep, voffB);
            PG8_WAIT_V(6); PG8_BAR; PG8_MMA(1, 1, At, B1); PG8_BAR;
            PG8_LDB(B0, 1, 0); PG8_SCHED; PG8_LDA(At, 1, 0); PG8_STAGE(PG8_SA(0, 1), a2 + hstep, voffA);
            PG8_WAIT_L(8); PG8_BAR; PG8_WAIT_L(0); PG8_MMA(0, 0, At, B0); PG8_BAR; PG8_SCHED;
            PG8_LDB(B1, 1, 1); PG8_STAGE(PG8_SB(1, 0), b3, voffB);
            PG8_BAR; PG8_WAIT_L(0); PG8_MMA(0, 1, At, B1); PG8_BAR;
            PG8_LDA(At, 1, 1); PG8_STAGE(PG8_SA(1, 0), a3, voffA);
            PG8_BAR; PG8_WAIT_L(0); PG8_MMA(1, 0, At, B0); PG8_BAR; PG8_SCHED;
            PG8_STAGE(PG8_SB(1, 1), b3 + hstep, voffB);
            PG8_WAIT_V(6); PG8_BAR; PG8_MMA(1, 1, At, B1); PG8_BAR;
            }
        }
        if constexpr (ALIGN_EPI) { if (wr == 0) PG8_BAR; }
        if constexpr (!Epi::AFTER_DRAIN) { E(acc, cur, wr, wc, fr, fq); S.done(cur); }
        if (!has_next) break;
#pragma unroll
        for (int a = 0; a < 2; ++a)
#pragma unroll
            for (int b = 0; b < 2; ++b)
#pragma unroll
                for (int m = 0; m < 4; ++m)
#pragma unroll
                    for (int n = 0; n < 2; ++n) acc[a][b][m][n] = (f32x4){0.f, 0.f, 0.f, 0.f};
        cur = nxt; cA = nA; cB = nB; ++ui;
        if constexpr (ALIGN_EPI) { if (wr == 1) PG8_BAR; }
    }
    PG8_WAIT_V(0);
    if constexpr (!ALIGN_EPI) { if (wr == 0) PG8_BAR; }
    PG8_BAR;
    if constexpr (Epi::AFTER_DRAIN) { E.fused(acc, cur, wr, wc, fr, fq, lds, wid, lane); S.done(cur); }
#undef PG8_SA
#undef PG8_SB
#undef PG8_STAGE
#undef PG8_LDA
#undef PG8_LDB
#undef PG8_MMA
#undef PG8_WAIT_V
#undef PG8_WAIT_L
#undef PG8_BAR
#undef PG8_SCHED
}
}
namespace att {
typedef unsigned short bf16_t;
typedef short bf16x8 __attribute__((ext_vector_type(8)));
typedef short s16x4 __attribute__((ext_vector_type(4)));
typedef float f32x16 __attribute__((ext_vector_type(16)));
typedef unsigned u32x4 __attribute__((ext_vector_type(4)));
constexpr float THR = 8.f;
#define SBAR() __builtin_amdgcn_sched_barrier(0)
__device__ __forceinline__ int crow(int r, int hi) { return (r & 3) + 8 * (r >> 2) + 4 * hi; }
__device__ __forceinline__ unsigned cvtpk(float lo, float hi) { return pg8::cvt_pk_bf16(lo, hi); }

struct Unit { const bf16_t* Q; const bf16_t* K; const bf16_t* V; bf16_t* O; float* LSE; int ldq, ldk, ldv, ldo, ldlse; int q0, L, kt0, kt1, R; };

template <int DK> struct Cfg { static constexpr float SCALE = (DK == 128) ? 0.08838834764831845f : 0.07216878364870323f; };

template <int DK>
__device__ __forceinline__ void partialSM(f32x16& p0, f32x16& p1, float& m_reg, float& mn, float& alpha) {
  constexpr float SCALE = Cfg<DK>::SCALE, C = SCALE * 1.4426950408889634f;
  float pmax = p0[0];
#pragma unroll
  for (int r = 1; r < 16; ++r) pmax = fmaxf(pmax, p0[r]);
#pragma unroll
  for (int r = 0; r < 16; ++r) pmax = fmaxf(pmax, p1[r]);
  { auto rr = __builtin_amdgcn_permlane32_swap(__float_as_uint(pmax), __float_as_uint(pmax), false, false);
    pmax = fmaxf(__uint_as_float(rr[0]), __uint_as_float(rr[1])); }
  if (__builtin_expect(__all(pmax - m_reg <= THR / SCALE), 1)) { mn = m_reg; alpha = 1.f; }
  else { mn = fmaxf(m_reg, pmax); alpha = __builtin_amdgcn_exp2f((m_reg - mn) * C); m_reg = mn; }
  const float mnC = -mn * C;
#pragma unroll
  for (int r = 0; r < 16; ++r) p0[r] = fmaf(p0[r], C, mnC);
#pragma unroll
  for (int r = 0; r < 16; ++r) p1[r] = fmaf(p1[r], C, mnC);
#pragma unroll
  for (int r = 0; r < 16; ++r) p0[r] = __builtin_amdgcn_exp2f(p0[r]);
}
__device__ __forceinline__ void finishSM(f32x16& p0, f32x16& p1, float alpha, float& l_reg, bf16x8& pa0, bf16x8& pa1, bf16x8& pa2, bf16x8& pa3) {
#pragma unroll
  for (int r = 0; r < 16; ++r) p1[r] = __builtin_amdgcn_exp2f(p1[r]);
  float ps = 0;
#pragma unroll
  for (int r = 0; r < 16; ++r) ps += p0[r];
#pragma unroll
  for (int r = 0; r < 16; ++r) ps += p1[r];
  { auto rr = __builtin_amdgcn_permlane32_swap(__float_as_uint(ps), __float_as_uint(ps), false, false);
    ps = __uint_as_float(rr[0]) + __uint_as_float(rr[1]); }
  l_reg = l_reg * alpha + ps;
#define PK4(P, BASE, OUT) do { unsigned a0 = cvtpk(P[BASE + 0], P[BASE + 1]), a1 = cvtpk(P[BASE + 2], P[BASE + 3]);   \
    unsigned b0 = cvtpk(P[BASE + 4], P[BASE + 5]), b1 = cvtpk(P[BASE + 6], P[BASE + 7]);                              \
    auto r0 = __builtin_amdgcn_permlane32_swap(a0, b0, false, false); auto r1 = __builtin_amdgcn_permlane32_swap(a1, b1, false, false); \
    u32x4 w = {r0[0], r1[0], r0[1], r1[1]}; OUT = *reinterpret_cast<bf16x8*>(&w); } while (0)
  PK4(p0, 0, pa0); PK4(p0, 8, pa1); PK4(p1, 0, pa2); PK4(p1, 8, pa3);
#undef PK4
}
__device__ __forceinline__ int v_st(int k, int c) { const int kk = (k & ~0xC) | ((k & 4) << 1) | ((k & 8) >> 1); return ((kk >> 3) * 4 + (c >> 5)) * 512 + ((kk & 7) * 32 + (c & 31)) * 2; }
__device__ __forceinline__ int v_rd_base(int lane) { return ((lane & 3) << 3) | (((lane >> 2) & 3) << 6) | (((lane >> 4) & 1) << 5) | (((lane >> 5) & 1) << 8); }
constexpr int v_rd_off(int d0, int ks, int half) { return d0 * 512 + ks * 4096 + half * 2048; }
template <int OFF> __device__ __forceinline__ s16x4 tr_read(int vb) {
  s16x4 r; asm volatile("ds_read_b64_tr_b16 %0, %1 offset:%2" : "=&v"(r) : "v"(vb), "i"(OFF) : "memory"); return r;
}
template <int D0> __device__ __forceinline__ void pv_one(f32x16& od, int vb, bf16x8 pa0, bf16x8 pa1, bf16x8 pa2, bf16x8 pa3) {
  const s16x4 l0 = tr_read<v_rd_off(D0, 0, 0)>(vb), h0 = tr_read<v_rd_off(D0, 0, 1)>(vb), l1 = tr_read<v_rd_off(D0, 1, 0)>(vb), h1 = tr_read<v_rd_off(D0, 1, 1)>(vb);
  const s16x4 l2 = tr_read<v_rd_off(D0, 2, 0)>(vb), h2 = tr_read<v_rd_off(D0, 2, 1)>(vb), l3 = tr_read<v_rd_off(D0, 3, 0)>(vb), h3 = tr_read<v_rd_off(D0, 3, 1)>(vb);
  asm volatile("s_waitcnt lgkmcnt(0)" ::: "memory"); SBAR();
#define PK(L, H) (bf16x8){L[0], L[1], L[2], L[3], H[0], H[1], H[2], H[3]}
  od = __builtin_amdgcn_mfma_f32_32x32x16_bf16(pa0, PK(l0, h0), od, 0, 0, 0);
  od = __builtin_amdgcn_mfma_f32_32x32x16_bf16(pa1, PK(l1, h1), od, 0, 0, 0);
  od = __builtin_amdgcn_mfma_f32_32x32x16_bf16(pa2, PK(l2, h2), od, 0, 0, 0);
  od = __builtin_amdgcn_mfma_f32_32x32x16_bf16(pa3, PK(l3, h3), od, 0, 0, 0);
#undef PK
}

template <int D0> __device__ __forceinline__ void pv_half(f32x16& od, int vb, bf16x8 pa0, bf16x8 pa1, bf16x8 pa2, bf16x8 pa3) {
#define PK(L, H) (bf16x8){L[0], L[1], L[2], L[3], H[0], H[1], H[2], H[3]}
  { const s16x4 l0 = tr_read<v_rd_off(D0, 0, 0)>(vb), h0 = tr_read<v_rd_off(D0, 0, 1)>(vb), l1 = tr_read<v_rd_off(D0, 1, 0)>(vb), h1 = tr_read<v_rd_off(D0, 1, 1)>(vb);
    asm volatile("s_waitcnt lgkmcnt(0)" ::: "memory"); SBAR();
    od = __builtin_amdgcn_mfma_f32_32x32x16_bf16(pa0, PK(l0, h0), od, 0, 0, 0);
    od = __builtin_amdgcn_mfma_f32_32x32x16_bf16(pa1, PK(l1, h1), od, 0, 0, 0); }
  { const s16x4 l2 = tr_read<v_rd_off(D0, 2, 0)>(vb), h2 = tr_read<v_rd_off(D0, 2, 1)>(vb), l3 = tr_read<v_rd_off(D0, 3, 0)>(vb), h3 = tr_read<v_rd_off(D0, 3, 1)>(vb);
    asm volatile("s_waitcnt lgkmcnt(0)" ::: "memory"); SBAR();
    od = __builtin_amdgcn_mfma_f32_32x32x16_bf16(pa2, PK(l2, h2), od, 0, 0, 0);
    od = __builtin_amdgcn_mfma_f32_32x32x16_bf16(pa3, PK(l3, h3), od, 0, 0, 0); }
#undef PK
}

__device__ __forceinline__ void store_o_tile(const f32x16 (&o)[4], const float* li_l, const Unit& u, char* lds, int wid, int lane, int r32, int hi) {
  float rl[16];
#pragma unroll
  for (int r = 0; r < 16; ++r) rl[r] = __builtin_amdgcn_rcpf(li_l[crow(r, hi)]);
  asm volatile("s_waitcnt lgkmcnt(0)" ::: "memory");
  __syncthreads();
  char* img = lds + wid * (32 * 272);
#pragma unroll
  for (int r = 0; r < 16; ++r) { const int orow = crow(r, hi);
#pragma unroll
    for (int d0 = 0; d0 < 4; ++d0) *(bf16_t*)(img + orow * 272 + (d0 * 32 + r32) * 2) = (bf16_t)(cvtpk(o[d0][r] * rl[r], 0.f) & 0xffffu); }
  asm volatile("s_waitcnt lgkmcnt(0)" ::: "memory");
  const int row_base = u.q0 + wid * 32;
  bf16_t* Ow = u.O + (size_t)row_base * u.ldo;
#pragma unroll
  for (int i = 0; i < 8; ++i) { const int ch = lane + 64 * i, r = ch >> 4, cc = ch & 15;
    const u32x4 v = *(const u32x4*)(img + r * 272 + cc * 16);
    if (row_base + r < u.L) *(u32x4*)(Ow + (size_t)r * u.ldo + cc * 8) = v; }
  __syncthreads();
}

template <int DK>
__device__ __forceinline__ void attn_unit(const Unit& u, char* lds) {
  constexpr int ND0 = DK / 16, NCK = DK / 8, NKI = DK / 64, KROWB = DK * 2;
  constexpr int SHM_V = 16384, SHM_K = 64 * KROWB;
  constexpr float SCALE = Cfg<DK>::SCALE;
#define KSWZ(row, colB) ((row) * KROWB + ((colB) ^ (((row) & 7) << 4)))
  int tid_ = threadIdx.x; asm volatile("" : "+v"(tid_));
  const int tid = tid_, wid = tid >> 6, lane = tid & 63, r32 = lane & 31, hi = lane >> 5;
  char* V_lds = lds; char* K_lds = lds + 2 * SHM_V;
  float* wsf = (float*)(lds + 2 * SHM_V + 2 * SHM_K) + wid * 64; float* li_l = wsf; float* al_l = wsf + 32;
  float m_reg = -1e30f, l_reg = 0.f; f32x16 o[4] = {}; bf16x8 qr[ND0];
  const int qrow = u.q0 + wid * 32 + r32;
  { const int qc = qrow < u.L ? qrow : u.L - 1;
    const bf16_t* Qw = u.Q + (size_t)qc * u.ldq + hi * 8;
#pragma unroll
    for (int d0 = 0; d0 < ND0; ++d0) qr[d0] = *reinterpret_cast<const bf16x8*>(Qw + d0 * 16); }
  const int sr = tid >> 4, sc = (tid & 15) * 8;
  const int vst0 = v_st(sr, sc), vst1 = v_st(32 + sr, sc);
  const unsigned voffV0 = (unsigned)(sr * u.ldv + sc) * 2u, voffV1 = (unsigned)((sr + 32) * u.ldv + sc) * 2u;
  unsigned voffK[NKI]; int kst[NKI];
#pragma unroll
  for (int i = 0; i < NKI; ++i) { const int c = tid + 512 * i, row = c / NCK, cc = c % NCK; voffK[i] = (unsigned)(row * u.ldk + cc * 8) * 2u; kst[i] = KSWZ(row, cc * 16); }
  const int vb0 = (int)(uintptr_t)V_lds + v_rd_base(lane);
  bf16x8 vs0, vs1, ks[NKI];
#define SLOAD(kt) do { const char* vb_ = (const char*)u.V + (size_t)(kt) * 64 * u.ldv * 2; const char* kb_ = (const char*)u.K + (size_t)(kt) * 64 * u.ldk * 2; \
    vs0 = *(const bf16x8*)(vb_ + voffV0); vs1 = *(const bf16x8*)(vb_ + voffV1); \
    _Pragma("unroll") for (int i_ = 0; i_ < NKI; ++i_) ks[i_] = *(const bf16x8*)(kb_ + voffK[i_]); } while (0)
#define SWRITE(b) do { *(bf16x8*)(V_lds + (b) * SHM_V + vst0) = vs0; *(bf16x8*)(V_lds + (b) * SHM_V + vst1) = vs1; \
    _Pragma("unroll") for (int i_ = 0; i_ < NKI; ++i_) *(bf16x8*)(K_lds + (b) * SHM_K + kst[i_]) = ks[i_]; } while (0)
  const bool masked = u.R < u.L;
  SLOAD(u.kt0); SWRITE(0); __syncthreads();
  for (int j = u.kt0; j < u.kt1; ++j) {
    const int b = (j - u.kt0) & 1; const bool more = (j + 1 < u.kt1);
    if (more) SLOAD(j + 1);
    f32x16 p0 = {}, p1 = {};
    { const char* Ks = K_lds + b * SHM_K; __builtin_amdgcn_s_setprio(1);
#pragma unroll
      for (int d0 = 0; d0 < ND0; ++d0) { const int cb = (d0 * 16 + hi * 8) * 2;
        const bf16x8 b0 = *reinterpret_cast<const bf16x8*>(Ks + KSWZ(r32, cb));
        const bf16x8 b1 = *reinterpret_cast<const bf16x8*>(Ks + KSWZ(32 + r32, cb));
        p0 = __builtin_amdgcn_mfma_f32_32x32x16_bf16(b0, qr[d0], p0, 0, 0, 0);
        p1 = __builtin_amdgcn_mfma_f32_32x32x16_bf16(b1, qr[d0], p1, 0, 0, 0); } __builtin_amdgcn_s_setprio(0); }
    if (masked) { const int d = qrow - j * 64 - 4 * hi, R = u.R;
#pragma unroll
      for (int r = 0; r < 16; ++r) { const int dl = d - ((r & 3) + 8 * (r >> 2));
        if (dl > R || dl < -R) p0[r] = -1e30f;
        if (dl - 32 > R || dl - 32 < -R) p1[r] = -1e30f; } }
    float mn, alpha; partialSM<DK>(p0, p1, m_reg, mn, alpha);
    if (__any(alpha < 1.f)) { if (hi == 0) al_l[r32] = alpha; asm volatile("s_waitcnt lgkmcnt(0)" ::: "memory");
#pragma unroll
      for (int dd = 0; dd < 4; ++dd)
#pragma unroll
        for (int r = 0; r < 16; ++r) o[dd][r] *= al_l[crow(r, hi)]; }
    bf16x8 pa0, pa1, pa2, pa3; finishSM(p0, p1, alpha, l_reg, pa0, pa1, pa2, pa3); SBAR();
    { const int vb = vb0 + b * SHM_V; __builtin_amdgcn_s_setprio(1);
      pv_one<0>(o[0], vb, pa0, pa1, pa2, pa3); pv_one<1>(o[1], vb, pa0, pa1, pa2, pa3); pv_one<2>(o[2], vb, pa0, pa1, pa2, pa3); pv_one<3>(o[3], vb, pa0, pa1, pa2, pa3); __builtin_amdgcn_s_setprio(0); }
    if (more) SWRITE(b ^ 1);
    __syncthreads();
  }
  if (hi == 0) li_l[r32] = l_reg; asm volatile("s_waitcnt lgkmcnt(0)" ::: "memory");
  if (u.LSE && hi == 0 && qrow < u.L) u.LSE[(size_t)qrow * u.ldlse] = m_reg * SCALE + logf(l_reg);
  store_o_tile(o, li_l, u, lds, wid, lane, r32, hi);
#undef SLOAD
#undef SWRITE
#undef KSWZ
}

template <int DK>
__device__ __forceinline__ void attn_unit_pipe(const Unit& u, char* lds) {
  constexpr int ND0 = DK / 16, NCK = DK / 8, NKI = DK / 64, KROWB = DK * 2;
  constexpr int SHM_V = 16384, SHM_K = 64 * KROWB;
  constexpr float SCALE = Cfg<DK>::SCALE;
#define KSWZ(row, colB) ((row) * KROWB + ((colB) ^ (((row) & 7) << 4)))
  int tid_ = threadIdx.x; asm volatile("" : "+v"(tid_));
  const int tid = tid_, wid = tid >> 6, lane = tid & 63, r32 = lane & 31, hi = lane >> 5;
  char* V_lds = lds; char* K_lds = lds + 2 * SHM_V;
  float* wsf = (float*)(lds + 2 * SHM_V + 2 * SHM_K) + wid * 64; float* li_l = wsf; float* al_l = wsf + 32;
  float m_reg = -1e30f, l_reg = 0.f; f32x16 o[4] = {}; bf16x8 qr[ND0];
  const int qrow = u.q0 + wid * 32 + r32;
  { const int qc = qrow < u.L ? qrow : u.L - 1;
    const bf16_t* Qw = u.Q + (size_t)qc * u.ldq + hi * 8;
#pragma unroll
    for (int d0 = 0; d0 < ND0; ++d0) qr[d0] = *reinterpret_cast<const bf16x8*>(Qw + d0 * 16); }
  const int sr = tid >> 4, sc = (tid & 15) * 8;
  const int vst0 = v_st(sr, sc), vst1 = v_st(32 + sr, sc);
  const unsigned voffV0 = (unsigned)(sr * u.ldv + sc) * 2u, voffV1 = (unsigned)((sr + 32) * u.ldv + sc) * 2u;
  unsigned voffK[NKI]; int kst[NKI];
#pragma unroll
  for (int i = 0; i < NKI; ++i) { const int c = tid + 512 * i, row = c / NCK, cc = c % NCK; voffK[i] = (unsigned)(row * u.ldk + cc * 8) * 2u; kst[i] = KSWZ(row, cc * 16); }
  const int vb0 = (int)(uintptr_t)V_lds + v_rd_base(lane);
  bf16x8 vs0, vs1, ks[NKI];
#define SLOAD(kt) do { const char* vb_ = (const char*)u.V + (size_t)(kt) * 64 * u.ldv * 2; const char* kb_ = (const char*)u.K + (size_t)(kt) * 64 * u.ldk * 2; \
    vs0 = *(const bf16x8*)(vb_ + voffV0); vs1 = *(const bf16x8*)(vb_ + voffV1); \
    _Pragma("unroll") for (int i_ = 0; i_ < NKI; ++i_) ks[i_] = *(const bf16x8*)(kb_ + voffK[i_]); } while (0)
#define SWRITE(b) do { *(bf16x8*)(V_lds + (b) * SHM_V + vst0) = vs0; *(bf16x8*)(V_lds + (b) * SHM_V + vst1) = vs1; \
    _Pragma("unroll") for (int i_ = 0; i_ < NKI; ++i_) *(bf16x8*)(K_lds + (b) * SHM_K + kst[i_]) = ks[i_]; } while (0)
#define QKT(P0, P1, b) do { P0 = f32x16{}; P1 = f32x16{}; const char* Ks = K_lds + (b) * SHM_K; \
    _Pragma("unroll") for (int d0 = 0; d0 < ND0; ++d0) { const int cb = (d0 * 16 + hi * 8) * 2; \
      const bf16x8 b0 = *reinterpret_cast<const bf16x8*>(Ks + KSWZ(r32, cb)); const bf16x8 b1 = *reinterpret_cast<const bf16x8*>(Ks + KSWZ(32 + r32, cb)); \
      P0 = __builtin_amdgcn_mfma_f32_32x32x16_bf16(b0, qr[d0], P0, 0, 0, 0); P1 = __builtin_amdgcn_mfma_f32_32x32x16_bf16(b1, qr[d0], P1, 0, 0, 0); } } while (0)
#define MASK(P0, P1, kt) do { if (masked) { const int d_ = qrow - (kt) * 64 - 4 * hi, R_ = u.R; \
    _Pragma("unroll") for (int r = 0; r < 16; ++r) { const int dl = d_ - ((r & 3) + 8 * (r >> 2)); \
      if (dl > R_ || dl < -R_) P0[r] = -1e30f; if (dl - 32 > R_ || dl - 32 < -R_) P1[r] = -1e30f; } } } while (0)
#define RESC(a) do { if (__any((a) < 1.f)) { if (hi == 0) al_l[r32] = (a); asm volatile("s_waitcnt lgkmcnt(0)" ::: "memory"); \
    _Pragma("unroll") for (int dd = 0; dd < 4; ++dd) _Pragma("unroll") for (int r = 0; r < 16; ++r) o[dd][r] *= al_l[crow(r, hi)]; } } while (0)
#ifdef ATT_PVHALF
#define PV(b) do { const int vb = vb0 + (b) * SHM_V; pv_half<0>(o[0], vb, pa0, pa1, pa2, pa3); pv_half<1>(o[1], vb, pa0, pa1, pa2, pa3); pv_half<2>(o[2], vb, pa0, pa1, pa2, pa3); pv_half<3>(o[3], vb, pa0, pa1, pa2, pa3); } while (0)
#else
#define PV(b) do { const int vb = vb0 + (b) * SHM_V; pv_one<0>(o[0], vb, pa0, pa1, pa2, pa3); pv_one<1>(o[1], vb, pa0, pa1, pa2, pa3); pv_one<2>(o[2], vb, pa0, pa1, pa2, pa3); pv_one<3>(o[3], vb, pa0, pa1, pa2, pa3); } while (0)
#endif
  const bool masked = u.R < u.L;
  const int NT = u.kt1 - u.kt0, k0 = u.kt0;
  f32x16 pA0, pA1, pB0, pB1; float mnA, mnB, alA, alB; bf16x8 pa0, pa1, pa2, pa3;
  SLOAD(k0); SWRITE(0); __syncthreads();
  QKT(pA0, pA1, 0); MASK(pA0, pA1, k0); partialSM<DK>(pA0, pA1, m_reg, mnA, alA);
  SLOAD(k0 + 1); SWRITE(1); __syncthreads();
  for (int j = 1; j + 1 < NT; j += 2) {
    SBAR(); QKT(pB0, pB1, 1); MASK(pB0, pB1, k0 + j);
    finishSM(pA0, pA1, alA, l_reg, pa0, pa1, pa2, pa3); SBAR();
    SLOAD(k0 + j + 1); SBAR();
    PV(0); partialSM<DK>(pB0, pB1, m_reg, mnB, alB);
    __syncthreads(); SWRITE(0);
    RESC(alB); __syncthreads();
    SBAR(); QKT(pA0, pA1, 0); MASK(pA0, pA1, k0 + j + 1);
    finishSM(pB0, pB1, alB, l_reg, pa0, pa1, pa2, pa3); SBAR();
    SLOAD(k0 + j + 2); SBAR();
    PV(1); partialSM<DK>(pA0, pA1, m_reg, mnA, alA);
    __syncthreads(); SWRITE(1);
    RESC(alA); __syncthreads();
  }
  SBAR(); QKT(pB0, pB1, 1); MASK(pB0, pB1, k0 + NT - 1);
  finishSM(pA0, pA1, alA, l_reg, pa0, pa1, pa2, pa3); SBAR();
  PV(0); partialSM<DK>(pB0, pB1, m_reg, mnB, alB);
  RESC(alB);
  finishSM(pB0, pB1, alB, l_reg, pa0, pa1, pa2, pa3); SBAR();
  PV(1);
  if (hi == 0) li_l[r32] = l_reg; asm volatile("s_waitcnt lgkmcnt(0)" ::: "memory");
  if (u.LSE && hi == 0 && qrow < u.L) u.LSE[(size_t)qrow * u.ldlse] = m_reg * SCALE + logf(l_reg);
  store_o_tile(o, li_l, u, lds, wid, lane, r32, hi);
#undef SLOAD
#undef SWRITE
#undef QKT
#undef MASK
#undef RESC
#undef PV
#undef KSWZ
}
}
#define LAS __attribute__((address_space(3)))
#define XB_TMO      128
#define XB_XCNT(j)  (256  + 64 * (j))
#define XB_XSUB(j)  (1280 + 64 * (j))
#define XB_XGEN(j)  (2304 + 64 * (j))
#define XB_TOP      3328
#define XB_TOPGEN   3392
#define XCD_BAR_WORDS 3456
#define XB_SPIN_CAP (1u << 18)

__device__ __forceinline__ unsigned xb_ld(unsigned* p)              { return __hip_atomic_load(p, __ATOMIC_RELAXED, __HIP_MEMORY_SCOPE_AGENT); }
__device__ __forceinline__ unsigned xb_add(unsigned* p, unsigned v) { return __hip_atomic_fetch_add(p, v, __ATOMIC_RELAXED, __HIP_MEMORY_SCOPE_AGENT); }
__device__ __forceinline__ unsigned xb_xcc_id() { return (unsigned)__builtin_amdgcn_s_getreg((3 << 11) | 20) & 0xFu; }
#define XB_SPIN(cond, bar) do { unsigned _sp = 0; while (cond) { __builtin_amdgcn_s_sleep(1); \
    if ((++_sp & 255u) == 0u) { if (xb_ld(&(bar)[XB_TMO])) break; if (_sp > XB_SPIN_CAP) { atomicAdd(&(bar)[XB_TMO], 1u); break; } } } } while (0)

struct XcdBarrier {
    unsigned* bar; unsigned x;
    volatile LAS unsigned* st;
};

__device__ __forceinline__ XcdBarrier xcd_barrier_post(unsigned* bar, volatile LAS unsigned* st) {
    XcdBarrier b; b.bar = bar; b.x = xb_xcc_id(); b.st = st;
    if (threadIdx.x == 0) (void)xb_add(&bar[XB_XCNT(b.x)], 1u);
    return b;
}
__device__ __forceinline__ void xcd_barrier_complete(unsigned* bar, unsigned x, unsigned& nloc, unsigned& nx) {
    const unsigned G = gridDim.x * gridDim.y * gridDim.z;
    unsigned sum, cnt, mine, sp = 0u;
    for (;;) {
        sum = 0u; cnt = 0u; mine = 0u;
#pragma unroll
        for (unsigned j = 0; j < 16; ++j) { const unsigned c = xb_ld(&bar[XB_XCNT(j)]); sum += c; cnt += (c > 0u) ? 1u : 0u; mine = (j == x) ? c : mine; }
        if (sum == G) break;
        __builtin_amdgcn_s_sleep(1);
        if ((++sp & 255u) == 0u) { if (xb_ld(&bar[XB_TMO])) break; if (sp > XB_SPIN_CAP) { atomicAdd(&bar[XB_TMO], 1u); break; } }
    }
    nloc = mine > 0u ? mine : 1u; nx = cnt > 0u ? cnt : 1u;
}

__device__ __forceinline__ void xcd_barrier(const XcdBarrier& b) {
    asm volatile("s_waitcnt vmcnt(0)" ::: "memory");
    __syncthreads();
    if (threadIdx.x == 0) {
        unsigned* bar = b.bar;
        __builtin_amdgcn_s_waitcnt(0);
        unsigned nloc = b.st[0], nx = b.st[1];
        if (nloc == 0u) { xcd_barrier_complete(bar, b.x, nloc, nx); b.st[0] = nloc; b.st[1] = nx; }
        const unsigned old = xb_add(&bar[XB_XSUB(b.x)], 1u);
        const unsigned gen = old / nloc;
        if (old + 1u == (gen + 1u) * nloc) {
            __builtin_amdgcn_fence(__ATOMIC_RELEASE, "agent");
            asm volatile("s_waitcnt vmcnt(0)" ::: "memory");
            const unsigned og = xb_add(&bar[XB_TOP], 1u);
            const unsigned tg = og / nx;
            if (og + 1u == (tg + 1u) * nx) xb_add(&bar[XB_TOPGEN], 1u);
            else XB_SPIN(xb_ld(&bar[XB_TOPGEN]) == tg, bar);
            __builtin_amdgcn_fence(__ATOMIC_ACQUIRE, "agent");
            xb_add(&bar[XB_XGEN(b.x)], 1u);
            asm volatile("s_waitcnt vmcnt(0)" ::: "memory");
        } else {
            XB_SPIN(xb_ld(&bar[XB_XGEN(b.x)]) == gen, bar);
            __builtin_amdgcn_fence(__ATOMIC_ACQUIRE, "agent");
            asm volatile("s_waitcnt vmcnt(0)" ::: "memory");
        }
    }
    __syncthreads();
}
typedef unsigned short bf16_t;
typedef float f32x4 __attribute__((ext_vector_type(4)));
typedef unsigned u32x4 __attribute__((ext_vector_type(4)));
typedef unsigned u32x2 __attribute__((ext_vector_type(2)));
constexpr int NWAVES = 8, NTHR = 512;
constexpr int LDS_BYTES = 135168;
constexpr int T = 16384, SEQ = 2048, DM = 2048, DEPTH = 2, DFF = 8192;
constexpr int IN_COLS = 13120, NPROJ = 7168, NGATE = 6144;
constexpr float EPS = 1e-6f;
constexpr size_t SZ_WIN = (size_t)NPROJ * 2048 * 2, SZ_WG = (size_t)NGATE * 2048 * 2, SZ_WUQ = (size_t)1536 * 512 * 2, SZ_WUKV = (size_t)2048 * 256 * 2,
                 SZ_WOA = (size_t)2048 * 1024 * 2, SZ_WOC = (size_t)2048 * 512 * 2, SZ_WOUT = (size_t)2048 * 2048 * 2, SZ_WUP = (size_t)8192 * 2048 * 2;
constexpr size_t OFF_WIN = 0, OFF_WG = OFF_WIN + SZ_WIN, OFF_WUQ = OFF_WG + SZ_WG, OFF_WUKV = OFF_WUQ + SZ_WUQ, OFF_WOA = OFF_WUKV + SZ_WUKV, OFF_WOB = OFF_WOA + SZ_WOA,
                 OFF_WOC = OFF_WOB + SZ_WOA, OFF_WOUT = OFF_WOC + SZ_WOC, OFF_WUP = OFF_WOUT + SZ_WOUT, OFF_WDN = OFF_WUP + SZ_WUP, OFF_XN = OFF_WDN + SZ_WUP;
constexpr size_t SZ_T2048B = (size_t)T * 2048 * 2;
constexpr size_t OFF_OA = OFF_XN + SZ_T2048B, OFF_OB = OFF_OA + (size_t)T * 1024 * 2;
constexpr size_t OFF_PA = OFF_OB + (size_t)T * 1024 * 2;
constexpr size_t OFF_CQN = OFF_PA + (size_t)T * 1024 * 4, OFF_CKVN = OFF_CQN + (size_t)T * 512 * 2;
constexpr size_t OFF_BIG = OFF_CKVN + (size_t)T * 256 * 2;
constexpr size_t OFF_PBC = OFF_BIG, OFF_QA = OFF_PBC + (size_t)T * 6144 * 2, OFF_KA = OFF_QA + (size_t)T * 1536 * 2, OFF_KVR = OFF_KA + (size_t)T * 1536 * 2;
constexpr size_t WS_END = OFF_KVR + SZ_T2048B;
constexpr size_t OFF_CTL = WS_END, CTL_BYTES = 16384, OFF_XB = WS_END + CTL_BYTES  , WS_TOTAL = OFF_XB + (size_t)T * 2048 * 2;
static_assert(XCD_BAR_WORDS * 4 <= CTL_BYTES, "ctl");
constexpr size_t OFF_OC3 = OFF_PA, OFF_LSE = OFF_OC3 + (size_t)3 * T * 512 * 2, OFF_OC = OFF_LSE + (size_t)3 * T * 4 * 4;
static_assert(OFF_OC + (size_t)T * 512 * 2 <= OFF_BIG, "OC overlay");
constexpr size_t OFF_SIG = OFF_BIG, OFF_MT = OFF_SIG + (size_t)T * 2048 * 4, OFF_MRG = OFF_MT + (size_t)T * 2048 * 4;
static_assert(OFF_MRG + SZ_T2048B <= WS_END, "merge overlay");
constexpr size_t OFF_H = OFF_BIG;
static_assert(OFF_H + (size_t)T * 8192 * 2 <= WS_END, "H overlay");

struct Args;
typedef const __attribute__((address_space(4))) Args* KArgs;
struct Args {
    const float *x, *attn_norm, *w_in, *b_gate, *q_lat_norm, *w_uq, *kv_lat_norm, *w_ukv, *q_head_norm, *k_head_norm, *gqa_q_norm, *gqa_k_norm, *dil_q_norm, *dil_k_norm,
                *w_oa, *w_ob, *w_oc, *w_out, *mlp_norm, *w_up, *w_down;
    float* out; unsigned char* ws;
};

__device__ __forceinline__ float bf2f(unsigned h) { return __uint_as_float(h << 16); }
__device__ __forceinline__ unsigned pk2(float lo, float hi) { return pg8::cvt_pk_bf16(lo, hi); }
__device__ __forceinline__ float wave_sum(float v) {
#pragma unroll
    for (int o = 1; o < 64; o <<= 1) v += __shfl_xor(v, o);
    return v;
}
struct TrItem { const float* W; bf16_t* WT; int ld, K, nblk, r; };
__device__ __forceinline__ void tr_load(const TrItem& it, float (&v)[32], int lane) {
    const int kb = it.r / it.nblk, nb = it.r - kb * it.nblk; const float* p = it.W + (size_t)(64 * kb + (lane >> 5)) * it.ld + 32 * nb + (lane & 31);
#pragma unroll
    for (int i = 0; i < 32; ++i) v[i] = p[(size_t)(2 * i) * it.ld];
}
__device__ __forceinline__ void tr_store(const TrItem& it, const float (&v)[32], LAS float* scr, int lane) {
    const int kb = it.r / it.nblk, nb = it.r - kb * it.nblk, k0 = 64 * kb, n0 = 32 * nb;
#pragma unroll
    for (int i = 0; i < 32; ++i) scr[(2 * i + (lane >> 5)) * 33 + (lane & 31)] = v[i];
    asm volatile("s_waitcnt lgkmcnt(0)" ::: "memory");
    const int c = lane & 7;
#pragma unroll
    for (int j = 0; j < 4; ++j) { const int n = (lane >> 3) + 8 * j; const LAS float* s = scr + (8 * c) * 33 + n;
        u32x4 o; o.x = pk2(s[0 * 33], s[1 * 33]); o.y = pk2(s[2 * 33], s[3 * 33]); o.z = pk2(s[4 * 33], s[5 * 33]); o.w = pk2(s[6 * 33], s[7 * 33]);
        *(u32x4*)(it.WT + (size_t)(n0 + n) * it.K + k0 + 8 * c) = o; }
    asm volatile("s_waitcnt lgkmcnt(0)" ::: "memory");
}
__device__ __forceinline__ void rms_rows_f32(const float* x, const float* gain, bf16_t* o, bf16_t* xb, int gw, int NGW, int lane) {
    const f32x4* gr = (const f32x4*)gain + lane; f32x4 g[8];
#pragma unroll
    for (int j = 0; j < 8; ++j) g[j] = gr[64 * j];
    f32x4 v[8];
    { const f32x4* xr = (const f32x4*)(x + (size_t)gw * 2048) + lane;
#pragma unroll
      for (int j = 0; j < 8; ++j) v[j] = xr[64 * j]; }
    for (int m = gw; m < T; m += NGW) {
        const int mn = (m + NGW < T) ? m + NGW : m; f32x4 vn[8];
        { const f32x4* xr = (const f32x4*)(x + (size_t)mn * 2048) + lane;
#pragma unroll
            for (int j = 0; j < 8; ++j) vn[j] = xr[64 * j]; }
        float s = 0.f;
#pragma unroll
        for (int j = 0; j < 8; ++j) s += (v[j].x * v[j].x + v[j].y * v[j].y) + (v[j].z * v[j].z + v[j].w * v[j].w);
        const float rs = rsqrtf(wave_sum(s) * (1.f / 2048.f) + EPS);
        u32x2* o8 = (u32x2*)(o + (size_t)m * 2048) + lane; u32x2* x8 = (u32x2*)(xb + (size_t)m * 2048) + lane;
#pragma unroll
        for (int j = 0; j < 8; ++j) { u32x2 w; w.x = pk2(v[j].x * rs * g[j].x, v[j].y * rs * g[j].y); w.y = pk2(v[j].z * rs * g[j].z, v[j].w * rs * g[j].w); o8[64 * j] = w;
            u32x2 c; c.x = pk2(v[j].x, v[j].y); c.y = pk2(v[j].z, v[j].w); x8[64 * j] = c; }
#pragma unroll
        for (int j = 0; j < 8; ++j) v[j] = vn[j];
    }
}
__device__ __forceinline__ void rms_rows_bf16(const bf16_t* xb, const float* gain, bf16_t* o, int gw, int NGW, int lane) {
    f32x4 g[8];
#pragma unroll
    for (int j = 0; j < 4; ++j) { const f32x4* gp = (const f32x4*)(gain + 8 * (lane + 64 * j)); g[2 * j] = gp[0]; g[2 * j + 1] = gp[1]; }
    u32x4 r[4];
    { const u32x4* xr = (const u32x4*)(xb + (size_t)gw * 2048) + lane;
#pragma unroll
      for (int j = 0; j < 4; ++j) r[j] = xr[64 * j]; }
    for (int m = gw; m < T; m += NGW) {
        const int mn = (m + NGW < T) ? m + NGW : m; u32x4 rn[4];
        { const u32x4* xr = (const u32x4*)(xb + (size_t)mn * 2048) + lane;
#pragma unroll
            for (int j = 0; j < 4; ++j) rn[j] = xr[64 * j]; }
        f32x4 v[8]; float s = 0.f;
#pragma unroll
        for (int j = 0; j < 4; ++j) { v[2 * j].x = bf2f(r[j].x & 0xffffu); v[2 * j].y = bf2f(r[j].x >> 16); v[2 * j].z = bf2f(r[j].y & 0xffffu); v[2 * j].w = bf2f(r[j].y >> 16);
            v[2 * j + 1].x = bf2f(r[j].z & 0xffffu); v[2 * j + 1].y = bf2f(r[j].z >> 16); v[2 * j + 1].z = bf2f(r[j].w & 0xffffu); v[2 * j + 1].w = bf2f(r[j].w >> 16); }
#pragma unroll
        for (int k = 0; k < 8; ++k) s += (v[k].x * v[k].x + v[k].y * v[k].y) + (v[k].z * v[k].z + v[k].w * v[k].w);
        const float rs = rsqrtf(wave_sum(s) * (1.f / 2048.f) + EPS);
        u32x4* o16 = (u32x4*)(o + (size_t)m * 2048) + lane;
#pragma unroll
        for (int j = 0; j < 4; ++j) { const f32x4 a = v[2 * j], b = v[2 * j + 1], ga = g[2 * j], gb = g[2 * j + 1]; u32x4 w;
            w.x = pk2(a.x * rs * ga.x, a.y * rs * ga.y); w.y = pk2(a.z * rs * ga.z, a.w * rs * ga.w); w.z = pk2(b.x * rs * gb.x, b.y * rs * gb.y); w.w = pk2(b.z * rs * gb.z, b.w * rs * gb.w); o16[64 * j] = w; }
#pragma unroll
        for (int j = 0; j < 4; ++j) r[j] = rn[j];
    }
}

__device__ __forceinline__ void phase_p0(KArgs ap, int l, const float* xin, LAS unsigned char* lds, int gw, int NGW, int wave, int lane) {
    asm volatile("" : "+v"(lane));
    LAS float* scr = (LAS float*)(lds + wave * 16384);
    unsigned char* ws = ap->ws;
    const float* w_in = ap->w_in + (size_t)l * 2048 * IN_COLS;
    constexpr int I1 = (2048 / 64) * (832 / 32), I2 = (2048 / 64) * (6144 / 32), I3 = I2, I4 = (512 / 64) * (1536 / 32), I5 = (256 / 64) * (2048 / 32), I6 = (1024 / 64) * (2048 / 32), I7 = I6,
                  I8 = (512 / 64) * (2048 / 32), I9 = (2048 / 64) * (2048 / 32), I10 = (2048 / 64) * (8192 / 32), I11 = (8192 / 64) * (2048 / 32);
    constexpr int NITEMS = I1 + I2 + I3 + I4 + I5 + I6 + I7 + I8 + I9 + I10 + I11;
    auto resolve = [&](int it) -> TrItem {
        int r = it;
        if (r < I1) return TrItem{w_in, (bf16_t*)(ws + OFF_WIN), IN_COLS, 2048, 832 / 32, r}; r -= I1;
        if (r < I2) return TrItem{w_in + 832, (bf16_t*)(ws + OFF_WIN) + (size_t)1024 * 2048, IN_COLS, 2048, 6144 / 32, r}; r -= I2;
        if (r < I3) return TrItem{w_in + 6976, (bf16_t*)(ws + OFF_WG), IN_COLS, 2048, 6144 / 32, r}; r -= I3;
        if (r < I4) return TrItem{ap->w_uq + (size_t)l * 512 * 1536, (bf16_t*)(ws + OFF_WUQ), 1536, 512, 1536 / 32, r}; r -= I4;
        if (r < I5) return TrItem{ap->w_ukv + (size_t)l * 256 * 2048, (bf16_t*)(ws + OFF_WUKV), 2048, 256, 2048 / 32, r}; r -= I5;
        if (r < I6) return TrItem{ap->w_oa + (size_t)l * 1024 * 2048, (bf16_t*)(ws + OFF_WOA), 2048, 1024, 2048 / 32, r}; r -= I6;
        if (r < I7) return TrItem{ap->w_ob + (size_t)l * 1024 * 2048, (bf16_t*)(ws + OFF_WOB), 2048, 1024, 2048 / 32, r}; r -= I7;
        if (r < I8) return TrItem{ap->w_oc + (size_t)l * 512 * 2048, (bf16_t*)(ws + OFF_WOC), 2048, 512, 2048 / 32, r}; r -= I8;
        if (r < I9) return TrItem{ap->w_out + (size_t)l * 2048 * 2048, (bf16_t*)(ws + OFF_WOUT), 2048, 2048, 2048 / 32, r}; r -= I9;
        if (r < I10) return TrItem{ap->w_up + (size_t)l * 2048 * 8192, (bf16_t*)(ws + OFF_WUP), 8192, 2048, 8192 / 32, r}; r -= I10;
        return TrItem{ap->w_down + (size_t)l * 8192 * 2048, (bf16_t*)(ws + OFF_WDN), 2048, 8192, 2048 / 32, r};
    };
    if (gw < NITEMS) {
        int it = gw; TrItem cur = resolve(it); float v[32]; tr_load(cur, v, lane);
        for (;;) {
            const int nit = it + NGW; const bool has = nit < NITEMS; TrItem nxt = cur; float vn[32];
            if (has) { nxt = resolve(nit); tr_load(nxt, vn, lane); }
            tr_store(cur, v, scr, lane);
            if (!has) break;
            cur = nxt; it = nit;
#pragma unroll
            for (int i = 0; i < 32; ++i) v[i] = vn[i];
        }
    }
    { u32x4* z = (u32x4*)((bf16_t*)(ws + OFF_WIN) + (size_t)832 * 2048); const int n16 = 192 * 2048 * 2 / 16;
      for (int i = gw * 64 + lane; i < n16; i += NGW * 64) z[i] = (u32x4){0u, 0u, 0u, 0u}; }
    const float* g = ap->attn_norm + (size_t)l * 2048;
    if (l == 0) rms_rows_f32(xin, g, (bf16_t*)(ws + OFF_XN), (bf16_t*)(ws + OFF_XB), gw, NGW, lane);
    else rms_rows_bf16((const bf16_t*)(ws + OFF_XB), g, (bf16_t*)(ws + OFF_XN), gw, NGW, lane);
}

__device__ __forceinline__ void phase_p2(KArgs ap, int l, int gw, int NGW, int lane) {
    asm volatile("" : "+v"(lane));
    unsigned char* ws = ap->ws;
    const bf16_t* PA = (const bf16_t*)(ws + OFF_PA); bf16_t* CQN = (bf16_t*)(ws + OFF_CQN); bf16_t* CKVN = (bf16_t*)(ws + OFF_CKVN); bf16_t* PBC = (bf16_t*)(ws + OFF_PBC);
    const float* gcq = ap->q_lat_norm + (size_t)l * 512; const float* gckv = ap->kv_lat_norm + (size_t)l * 256;
    const int q = lane & 15;
    f32x4 G[4][2];
    { const float* gp[4] = {ap->gqa_q_norm + l * 128, ap->gqa_k_norm + l * 128, ap->dil_q_norm + l * 128, ap->dil_k_norm + l * 128};
#pragma unroll
      for (int k = 0; k < 4; ++k) { G[k][0] = *(const f32x4*)(gp[k] + 8 * q); G[k][1] = *(const f32x4*)(gp[k] + 8 * q + 4); } }
    const f32x4 gq0 = *(const f32x4*)(gcq + 4 * lane), gq1 = *(const f32x4*)(gcq + 256 + 4 * lane), gkv = *(const f32x4*)(gckv + 4 * lane);
    constexpr float L2A = 13.287712379549449f  , L2P = 18.931568569324174f  ;
    float inv_ax[8], inv_pr[8];
#pragma unroll
    for (int j = 0; j < 8; ++j) { inv_ax[j] = exp2f(-(float)(8 * (q & 3) + j) * (L2A / 32.0f)); inv_pr[j] = exp2f(-(float)(8 * (q & 1) + j) * (L2P / 16.0f)); }
    const bool ax_first = !(q & 4), pr_first = q < 2, pr_on = q < 4;
#define P2_CV(R) (f32x4){bf2f((R).x & 0xffffu), bf2f((R).x >> 16), bf2f((R).y & 0xffffu), bf2f((R).y >> 16)}
#define P2_LOADA(mm, A0, A1, A2) do { const bf16_t* pa_ = PA + (size_t)(mm) * 1024; A0 = *(const u32x2*)(pa_ + 4 * lane); A1 = *(const u32x2*)(pa_ + 256 + 4 * lane); A2 = *(const u32x2*)(pa_ + 512 + 4 * lane); } while (0)
#define P2_LOADW(mm, I0_, N_, W) do { const bf16_t* row_ = PBC + (size_t)(mm) * 6144 + 8 * lane; _Pragma("unroll") for (int k = 0; k < (N_); ++k) W[k] = *(const u32x4*)(row_ + ((I0_) + k) * 512); } while (0)
#define P2_PROC(I0_, N_, W) do { _Pragma("unroll") for (int k = 0; k < (N_); ++k) { const int I = (I0_) + k; const int kind = I < 2 ? 0 : (I == 2 ? 1 : (I < 6 ? 2 : 3)); \
        const u32x4 w_ = W[k]; float x[8] = {bf2f(w_.x & 0xffffu), bf2f(w_.x >> 16), bf2f(w_.y & 0xffffu), bf2f(w_.y >> 16), bf2f(w_.z & 0xffffu), bf2f(w_.z >> 16), bf2f(w_.w & 0xffffu), bf2f(w_.w >> 16)}; \
        float s_ = 0.f; _Pragma("unroll") for (int j = 0; j < 8; ++j) s_ += x[j] * x[j]; \
        s_ += __shfl_xor(s_, 1); s_ += __shfl_xor(s_, 2); s_ += __shfl_xor(s_, 4); s_ += __shfl_xor(s_, 8); \
        const float rs_ = rsqrtf(s_ * (1.f / 128.f) + EPS); const f32x4 ga = G[kind][0], gb = G[kind][1]; \
        float y[8] = {x[0] * rs_ * ga.x, x[1] * rs_ * ga.y, x[2] * rs_ * ga.z, x[3] * rs_ * ga.w, x[4] * rs_ * gb.x, x[5] * rs_ * gb.y, x[6] * rs_ * gb.z, x[7] * rs_ * gb.w}; \
        if (kind < 2) { _Pragma("unroll") for (int j = 0; j < 8; ++j) { const float p_ = __shfl_xor(y[j], 4); y[j] = y[j] * cax[j] + p_ * sax[j]; } } \
        else { _Pragma("unroll") for (int j = 0; j < 8; ++j) { const float p_ = __shfl_xor(y[j], 2); if (pr_on) y[j] = y[j] * cpr[j] + p_ * spr[j]; } } \
        u32x4 o_; o_.x = pk2(y[0], y[1]); o_.y = pk2(y[2], y[3]); o_.z = pk2(y[4], y[5]); o_.w = pk2(y[6], y[7]); \
        if (I != 2 || lane < 32) *(u32x4*)(row + I * 512 + 8 * lane) = o_; } } while (0)
    u32x2 ra0, ra1, ra2; u32x4 w1[5], w2[4];
    P2_LOADA(gw, ra0, ra1, ra2); P2_LOADW(gw, 0, 5, w1);
    int t_tab = -1; float cax[8], sax[8], cpr[8], spr[8];
#pragma unroll
    for (int j = 0; j < 8; ++j) { cax[j] = 1.f; sax[j] = 0.f; cpr[j] = 1.f; spr[j] = 0.f; }
    for (int m = gw; m < T; m += NGW) {
        const int t = m & (SEQ - 1);
        const int mn = (m + NGW < T) ? m + NGW : m;
        bf16_t* row = PBC + (size_t)m * 6144;
        if (t != t_tab) { t_tab = t;
            const float posax = (q & 8) ? (float)(t & 63) : (float)(t >> 6);
#pragma unroll
            for (int j = 0; j < 8; ++j) { const float a = posax * inv_ax[j]; cax[j] = cosf(a); const float sn = sinf(a); sax[j] = ax_first ? -sn : sn;
                const float b = (float)t * inv_pr[j]; cpr[j] = cosf(b); const float sp = sinf(b); spr[j] = pr_first ? -sp : sp; } }
        __builtin_amdgcn_sched_barrier(0);
        P2_LOADW(m, 5, 4, w2);
        __builtin_amdgcn_sched_barrier(0);
        { const f32x4 v0 = P2_CV(ra0), v1 = P2_CV(ra1), v2 = P2_CV(ra2);
          float s0 = (v0.x * v0.x + v0.y * v0.y) + (v0.z * v0.z + v0.w * v0.w) + (v1.x * v1.x + v1.y * v1.y) + (v1.z * v1.z + v1.w * v1.w);
          float s1 = (v2.x * v2.x + v2.y * v2.y) + (v2.z * v2.z + v2.w * v2.w);
#pragma unroll
          for (int o = 1; o < 64; o <<= 1) { s0 += __shfl_xor(s0, o); s1 += __shfl_xor(s1, o); }
          { const float rs = rsqrtf(s0 * (1.f / 512.f) + EPS);
            u32x2 qq; qq.x = pk2(v0.x * rs * gq0.x, v0.y * rs * gq0.y); qq.y = pk2(v0.z * rs * gq0.z, v0.w * rs * gq0.w); *(u32x2*)(CQN + (size_t)m * 512 + 4 * lane) = qq;
            qq.x = pk2(v1.x * rs * gq1.x, v1.y * rs * gq1.y); qq.y = pk2(v1.z * rs * gq1.z, v1.w * rs * gq1.w); *(u32x2*)(CQN + (size_t)m * 512 + 256 + 4 * lane) = qq; }
          { const float rs = rsqrtf(s1 * (1.f / 256.f) + EPS);
            u32x2 qq; qq.x = pk2(v2.x * rs * gkv.x, v2.y * rs * gkv.y); qq.y = pk2(v2.z * rs * gkv.z, v2.w * rs * gkv.w); *(u32x2*)(CKVN + (size_t)m * 256 + 4 * lane) = qq; } }
        __builtin_amdgcn_sched_barrier(0);
        P2_LOADA(mn, ra0, ra1, ra2);
        __builtin_amdgcn_sched_barrier(0);
        P2_PROC(0, 5, w1);
        __builtin_amdgcn_sched_barrier(0);
        P2_LOADW(mn, 0, 5, w1);
        __builtin_amdgcn_sched_barrier(0);
        P2_PROC(5, 4, w2);
    }
#undef P2_LOADA
#undef P2_CV
#undef P2_LOADW
#undef P2_PROC
}

__device__ __forceinline__ void phase_p3b(KArgs ap, int l, int gw, int NGW, int lane) {
    asm volatile("" : "+v"(lane));
    unsigned char* ws = ap->ws;
    const bf16_t* PA = (const bf16_t*)(ws + OFF_PA); bf16_t* QA = (bf16_t*)(ws + OFF_QA); bf16_t* KA = (bf16_t*)(ws + OFF_KA); const bf16_t* KVR = (const bf16_t*)(ws + OFF_KVR);
    const int p = lane & 31, half = lane >> 5; const bool act = p < 24, rope = act && p >= 16; const int pc = act ? p : 0;
    const float* gq = ap->q_head_norm + (size_t)l * 192; const float* gk = ap->k_head_norm + (size_t)l * 192;
    const f32x4 gqa = *(const f32x4*)(gq + 8 * pc), gqb = *(const f32x4*)(gq + 8 * pc + 4), gka = *(const f32x4*)(gk + 8 * pc), gkb = *(const f32x4*)(gk + 8 * pc + 4);
    constexpr float L2A = 13.287712379549449f;
    float inv[8];
#pragma unroll
    for (int j = 0; j < 8; ++j) inv[j] = exp2f(-(float)(8 * (p & 3) + j) * (L2A / 32.0f));
    const bool first = !(p & 4);
    const u32x4 zero4 = {0u, 0u, 0u, 0u};
#define P3B_LOAD(mm, QW, KW, KP) do { const bf16_t* q_ = QA + (size_t)(mm) * 1536 + half * 192 + 8 * pc; const bf16_t* kv_ = KVR + (size_t)(mm) * 2048 + half * 256 + 8 * pc; \
        _Pragma("unroll") for (int i = 0; i < 4; ++i) { QW[i] = *(const u32x4*)(q_ + i * 384); KW[i] = (p < 16) ? *(const u32x4*)(kv_ + i * 512) : zero4; } \
        KP = rope ? *(const u32x4*)(PA + (size_t)(mm) * 1024 + 768 + 8 * (p - 16)) : zero4; } while (0)
#define P3B_UNPK(W, X) float X[8] = {bf2f(W.x & 0xffffu), bf2f(W.x >> 16), bf2f(W.y & 0xffffu), bf2f(W.y >> 16), bf2f(W.z & 0xffffu), bf2f(W.z >> 16), bf2f(W.w & 0xffffu), bf2f(W.w >> 16)}
#define P3B_NORM(X, GA, GB, DST) do { float s_ = 0.f; if (act) { _Pragma("unroll") for (int j = 0; j < 8; ++j) s_ += X[j] * X[j]; } \
        s_ += __shfl_xor(s_, 1); s_ += __shfl_xor(s_, 2); s_ += __shfl_xor(s_, 4); s_ += __shfl_xor(s_, 8); s_ += __shfl_xor(s_, 16); \
        const float rs_ = rsqrtf(s_ * (1.f / 192.f) + EPS); \
        float y[8] = {X[0] * rs_ * GA.x, X[1] * rs_ * GA.y, X[2] * rs_ * GA.z, X[3] * rs_ * GA.w, X[4] * rs_ * GB.x, X[5] * rs_ * GB.y, X[6] * rs_ * GB.z, X[7] * rs_ * GB.w}; \
        _Pragma("unroll") for (int j = 0; j < 8; ++j) { const float p_ = __shfl_xor(y[j], 4); if (rope) y[j] = y[j] * cs[j] + p_ * sn[j]; } \
        u32x4 o_; o_.x = pk2(y[0], y[1]); o_.y = pk2(y[2], y[3]); o_.z = pk2(y[4], y[5]); o_.w = pk2(y[6], y[7]); if (act) *(u32x4*)(DST) = o_; } while (0)
    u32x4 qw[4], kw[4], kp;
    P3B_LOAD(gw, qw, kw, kp);
    int t_tab = -1; float cs[8], sn[8];
#pragma unroll
    for (int j = 0; j < 8; ++j) { cs[j] = 1.f; sn[j] = 0.f; }
    for (int m = gw; m < T; m += NGW) {
        const int t = m & (SEQ - 1);
        bf16_t* qrow = QA + (size_t)m * 1536 + half * 192 + 8 * pc; bf16_t* krow = KA + (size_t)m * 1536 + half * 192 + 8 * pc;
        const int mn = (m + NGW < T) ? m + NGW : m;
        u32x4 qwn[4], kwn[4], kpn;
        P3B_LOAD(mn, qwn, kwn, kpn);
        if (t != t_tab) { t_tab = t;
#pragma unroll
            for (int j = 0; j < 8; ++j) { const float a = (float)t * inv[j]; cs[j] = cosf(a); const float s = sinf(a); sn[j] = first ? -s : s; } }
#pragma unroll
        for (int i = 0; i < 4; ++i) {
            { P3B_UNPK(qw[i], x); P3B_NORM(x, gqa, gqb, qrow + i * 384); }
            { const u32x4 kk = (p < 16) ? kw[i] : kp; P3B_UNPK(kk, x); P3B_NORM(x, gka, gkb, krow + i * 384); }
        }
#pragma unroll
        for (int i = 0; i < 4; ++i) { qw[i] = qwn[i]; kw[i] = kwn[i]; }
        kp = kpn;
    }
#undef P3B_LOAD
#undef P3B_UNPK
#undef P3B_NORM
}

__device__ __forceinline__ void phase_p4(KArgs ap, unsigned char* lds_g, int G, int bid) {
    unsigned char* ws = ap->ws;
    bf16_t* PBC = (bf16_t*)(ws + OFF_PBC); bf16_t* QA = (bf16_t*)(ws + OFF_QA); bf16_t* KA = (bf16_t*)(ws + OFF_KA); bf16_t* KVR = (bf16_t*)(ws + OFF_KVR);
    bf16_t* OA = (bf16_t*)(ws + OFF_OA); bf16_t* OB = (bf16_t*)(ws + OFF_OB); bf16_t* OC3 = (bf16_t*)(ws + OFF_OC3); float* LSE = (float*)(ws + OFF_LSE);
    for (int i = bid; i < 2048; i += G) {
        att::Unit u;
        if (i < 512) {
            const int xs_ = i & 255, bh_ = (i >> 8) * 32 + (xs_ & 7) * 4 + (xs_ >> 6), b = bh_ >> 3, h = bh_ & 7, qb = (xs_ >> 3) & 7; const size_t tb = (size_t)b * SEQ;
            u.Q = QA + tb * 1536 + h * 192; u.K = KA + tb * 1536 + h * 192; u.V = KVR + tb * 2048 + h * 256 + 128; u.O = OA + tb * 1024 + h * 128; u.LSE = nullptr;
            u.ldq = 1536; u.ldk = 1536; u.ldv = 2048; u.ldo = 1024; u.ldlse = 0; u.q0 = qb * 256; u.L = SEQ; u.kt0 = 0; u.kt1 = 32; u.R = 1 << 30;
#ifdef ATT_PIPE192
            att::attn_unit_pipe<192>(u, (char*)lds_g);
#else
            att::attn_unit<192>(u, (char*)lds_g);
#endif
        } else {
            if (i < 1024) {
                const int j = i - 512, xs_ = j & 255, bh_ = (j >> 8) * 32 + (xs_ & 7) * 4 + (xs_ >> 6), b = bh_ >> 3, h = bh_ & 7, qb = (xs_ >> 3) & 7, kvh = h >> 2; const size_t tb = (size_t)b * SEQ;
                u.Q = PBC + tb * 6144 + h * 128; u.K = PBC + tb * 6144 + 1024 + kvh * 128; u.V = PBC + tb * 6144 + 1280 + kvh * 128; u.O = OB + tb * 1024 + h * 128; u.LSE = nullptr;
                u.ldq = 6144; u.ldk = 6144; u.ldv = 6144; u.ldo = 1024; u.ldlse = 0; u.q0 = qb * 256; u.L = SEQ; u.kt0 = 0; u.kt1 = 32; u.R = 1 << 30;
            } else {
                int g, b, h, r, qb, dil, L;
                if (i < 1280) { const int j = i - 1024, bh_ = (j & 7) * 4 + (j >> 6); g = 0; b = bh_ >> 2; h = bh_ & 3; r = 0; qb = (j >> 3) & 7; dil = 1; L = 2048; }
                else if (i < 1536) { const int j = i - 1280; g = 1; b = j >> 5; h = (j >> 3) & 3; r = (j >> 1) & 3; qb = j & 1; dil = 4; L = 512; }
                else { const int j = i - 1536; g = 2; b = j >> 6; h = (j >> 4) & 3; r = j & 15; qb = 0; dil = 16; L = 128; }
                const size_t tok = (size_t)b * SEQ + r; const int hd = g * 4 + h;
                u.Q = PBC + tok * 6144 + 1536 + hd * 128; u.K = PBC + tok * 6144 + 3072 + hd * 128; u.V = PBC + tok * 6144 + 4608 + hd * 128;
                u.O = OC3 + (size_t)g * T * 512 + tok * 512 + h * 128; u.LSE = LSE + (size_t)g * T * 4 + tok * 4 + h;
                u.ldq = u.ldk = u.ldv = dil * 6144; u.ldo = dil * 512; u.ldlse = dil * 4; u.q0 = qb * 256; u.L = L; u.R = 64;
                const int klo = u.q0 - 64 < 0 ? 0 : u.q0 - 64, khi = u.q0 + 320 > L ? L : u.q0 + 320;
                u.kt0 = klo >> 6; u.kt1 = khi >> 6;
                if ((u.kt1 - u.kt0) & 1) { if (u.kt0 > 0) --u.kt0; else ++u.kt1; }
            }
#ifdef ATT_PIPE128
            att::attn_unit_pipe<128>(u, (char*)lds_g);
#else
            att::attn_unit<128>(u, (char*)lds_g);
#endif
        }
    }
}

__device__ __forceinline__ void phase_p4b(KArgs ap, int gtid, int NGT) {
    asm volatile("" : "+v"(gtid));
    unsigned char* ws = ap->ws;
    const bf16_t* OC3 = (const bf16_t*)(ws + OFF_OC3); const float* LSE = (const float*)(ws + OFF_LSE); bf16_t* OC = (bf16_t*)(ws + OFF_OC);
#define P4B_LOAD(ii, L0, L1, L2, V0, V1, V2) do { const int m_ = (ii) >> 6, c_ = (ii) & 63, h_ = c_ >> 4; \
        L0 = LSE[(size_t)m_ * 4 + h_]; L1 = LSE[(size_t)T * 4 + (size_t)m_ * 4 + h_]; L2 = LSE[(size_t)2 * T * 4 + (size_t)m_ * 4 + h_]; \
        V0 = *(const u32x4*)(OC3 + (size_t)m_ * 512 + c_ * 8); V1 = *(const u32x4*)(OC3 + (size_t)T * 512 + (size_t)m_ * 512 + c_ * 8); V2 = *(const u32x4*)(OC3 + (size_t)2 * T * 512 + (size_t)m_ * 512 + c_ * 8); } while (0)
    float l0, l1, l2; u32x4 v0, v1, v2;
    if (gtid < T * 64) P4B_LOAD(gtid, l0, l1, l2, v0, v1, v2);
    for (int i = gtid; i < T * 64; i += NGT) {
        const int in = (i + NGT < T * 64) ? i + NGT : i;
        float n0, n1, n2; u32x4 w0, w1_, w2_;
        P4B_LOAD(in, n0, n1, n2, w0, w1_, w2_);
        const int m = i >> 6, c = i & 63;
        const float mx = fmaxf(l0, fmaxf(l1, l2)); float a0 = __expf(l0 - mx), a1 = __expf(l1 - mx), a2 = __expf(l2 - mx); const float inv = 1.f / (a0 + a1 + a2); a0 *= inv; a1 *= inv; a2 *= inv;
        u32x4 o;
#pragma unroll
        for (int e = 0; e < 4; ++e) { const float lo = a0 * bf2f(v0[e] & 0xffffu) + a1 * bf2f(v1[e] & 0xffffu) + a2 * bf2f(v2[e] & 0xffffu);
            const float hi = a0 * bf2f(v0[e] >> 16) + a1 * bf2f(v1[e] >> 16) + a2 * bf2f(v2[e] >> 16); o[e] = pk2(lo, hi); }
        *(u32x4*)(OC + (size_t)m * 512 + c * 8) = o;
        l0 = n0; l1 = n1; l2 = n2; v0 = w0; v1 = w1_; v2 = w2_;
    }
#undef P4B_LOAD
}

#ifndef GEMM_ALIGN
#define GEMM_ALIGN true
#endif
#ifndef GEMM_SP2
#define GEMM_SP2 true
#endif
template <class Epi>
__device__ __forceinline__ void run_gemm(LAS unsigned char* lds, const bf16_t* A, const bf16_t* Bt, int N, int K, const Epi& E, int G, int bid) {
    pg8::Gemm g{A, Bt, T, N, K}; pg8::StaticOrder S; S.init(T, N, G, bid);
    pg8::gemm_phase<Epi, pg8::StaticOrder, GEMM_ALIGN, GEMM_SP2>(lds, g, S, E);
}

#define KARGS KArgs ap = (KArgs)__builtin_amdgcn_kernarg_segment_ptr(); asm volatile("" : "+s"(ap)); unsigned char* ws = ap->ws; int bid = blockIdx.x; asm volatile("" : "+s"(bid)); \
    const int G = gridDim.x; (void)ws; (void)bid; (void)G
#define WAVEIDS int tid = threadIdx.x; asm volatile("" : "+v"(tid)); const int lane = tid & 63, wave = __builtin_amdgcn_readfirstlane(tid >> 6); const int gw = bid * NWAVES + wave, NGW = G * NWAVES; (void)lane; (void)gw; (void)NGW
__global__ void __launch_bounds__(NTHR, 2) fwd_kernel(Args a_unused) {
    extern __shared__ __attribute__((aligned(16))) unsigned char lds_g[];
    cg::grid_group grid = cg::this_grid();
    LAS unsigned char* lds = (LAS unsigned char*)lds_g;
    volatile LAS unsigned* bst = (volatile LAS unsigned*)(lds + 131072);
    if (threadIdx.x < 2) bst[threadIdx.x] = 0u;
    __syncthreads();
    { KARGS; (void)xcd_barrier_post((unsigned*)(ws + OFF_CTL), bst); }
#define GRID_BAR() do { KARGS; XcdBarrier b_; b_.bar = (unsigned*)(ws + OFF_CTL); b_.x = xb_xcc_id(); b_.st = bst; xcd_barrier(b_); } while (0)
#pragma unroll 1
    for (int l = 0; l < DEPTH; ++l) {
#ifndef NO_P0
        { KARGS; WAVEIDS; phase_p0(ap, l, (l == 0) ? ap->x : ap->out, lds, gw, NGW, wave, lane); }
#ifdef PROBE_P0X2
        if (l == 0) grid.sync(); else GRID_BAR();
        { KARGS; WAVEIDS; phase_p0(ap, l, (l == 0) ? ap->x : ap->out, lds, gw, NGW, wave, lane); }
#endif
#ifdef PROBE_SYNCS
#pragma unroll 1
        for (int q = 0; q < 20; ++q) GRID_BAR();
#endif
#endif
        GRID_BAR();
#ifndef NO_P1
        { KARGS; pg8::EpiProj E{(bf16_t*)(ws + OFF_PA), 1024, 4, (bf16_t*)(ws + OFF_PBC), 6144}; run_gemm(lds, (const bf16_t*)(ws + OFF_XN), (const bf16_t*)(ws + OFF_WIN), NPROJ, 2048, E, G, bid); }
#endif
        GRID_BAR();
#ifndef NO_P2
        { KARGS; WAVEIDS; phase_p2(ap, l, gw, NGW, lane); }
#endif
        GRID_BAR();
#ifndef NO_P3
        { KARGS; pg8::EpiBf16<0> E{(bf16_t*)(ws + OFF_QA), 1536}; run_gemm(lds, (const bf16_t*)(ws + OFF_CQN), (const bf16_t*)(ws + OFF_WUQ), 1536, 512, E, G, bid); }
        { KARGS; pg8::EpiBf16<0> E{(bf16_t*)(ws + OFF_KVR), 2048}; run_gemm(lds, (const bf16_t*)(ws + OFF_CKVN), (const bf16_t*)(ws + OFF_WUKV), 2048, 256, E, G, bid); }
#ifdef PROBE_P3X2
        { KARGS; pg8::EpiBf16<0> E{(bf16_t*)(ws + OFF_QA), 1536}; run_gemm(lds, (const bf16_t*)(ws + OFF_CQN), (const bf16_t*)(ws + OFF_WUQ), 1536, 512, E, G, bid); }
        { KARGS; pg8::EpiBf16<0> E{(bf16_t*)(ws + OFF_KVR), 2048}; run_gemm(lds, (const bf16_t*)(ws + OFF_CKVN), (const bf16_t*)(ws + OFF_WUKV), 2048, 256, E, G, bid); }
#endif
#endif
        GRID_BAR();
#ifndef NO_P3B
        { KARGS; WAVEIDS; phase_p3b(ap, l, gw, NGW, lane); }
#endif
        GRID_BAR();
#ifndef NO_P4
        { KARGS; phase_p4(ap, lds_g, G, bid); }
#ifdef PROBE_P4X2
        GRID_BAR();
        { KARGS; phase_p4(ap, lds_g, G, bid); }
#endif
#endif
        GRID_BAR();
#ifndef NO_P4B
        { KARGS; int tid = threadIdx.x; phase_p4b(ap, bid * NTHR + tid, G * NTHR); }
#endif
        GRID_BAR();
#ifndef NO_P5
#ifdef PROBE_P5X2
#pragma unroll 1
        for (int rep = 0; rep < 2; ++rep)
#endif
#pragma unroll 1
        for (int i = 0; i < 3; ++i) {
            { KARGS; pg8::EpiSig E{(u32x4*)(ws + OFF_SIG), ap->b_gate + (size_t)l * NGATE + i * 2048, 8};
              run_gemm(lds, (const bf16_t*)(ws + OFF_XN), (const bf16_t*)(ws + OFF_WG) + (size_t)i * 2048 * 2048, 2048, 2048, E, G, bid); }
#ifdef PROBE_GATEX2
            { KARGS; pg8::EpiSig E{(u32x4*)(ws + OFF_SIG), ap->b_gate + (size_t)l * NGATE + i * 2048, 8};
              run_gemm(lds, (const bf16_t*)(ws + OFF_XN), (const bf16_t*)(ws + OFF_WG) + (size_t)i * 2048 * 2048, 2048, 2048, E, G, bid); }
#endif
            { KARGS; const bf16_t* A = (const bf16_t*)(ws + (i == 0 ? OFF_OA : (i == 1 ? OFF_OB : OFF_OC)));
              const bf16_t* Bt = (const bf16_t*)(ws + (i == 0 ? OFF_WOA : (i == 1 ? OFF_WOB : OFF_WOC)));
              pg8::EpiGate E{(const u32x4*)(ws + OFF_SIG), (u32x4*)(ws + OFF_MT), (bf16_t*)(ws + OFF_MRG), 2048, 8, i};
              run_gemm(lds, A, Bt, 2048, i == 2 ? 512 : 1024, E, G, bid); }
        }
#endif
        GRID_BAR();
#ifndef NO_P6
        { KARGS; pg8::EpiResidB<false> E{(const bf16_t*)(ws + OFF_XB), (bf16_t*)(ws + OFF_XB), nullptr, 2048}; run_gemm(lds, (const bf16_t*)(ws + OFF_MRG), (const bf16_t*)(ws + OFF_WOUT), 2048, 2048, E, G, bid); }
#endif
        GRID_BAR();
        { KARGS; WAVEIDS; const float* g = ap->mlp_norm + (size_t)l * 2048; const float* xo = ap->out;
          rms_rows_bf16((const bf16_t*)(ws + OFF_XB), g, (bf16_t*)(ws + OFF_XN), gw, NGW, lane); (void)xo; }
        GRID_BAR();
#ifndef NO_P8
        { KARGS; pg8::EpiBf16<1> E{(bf16_t*)(ws + OFF_H), 8192}; run_gemm(lds, (const bf16_t*)(ws + OFF_XN), (const bf16_t*)(ws + OFF_WUP), 8192, 2048, E, G, bid); }
#ifdef PROBE_P8X2
        GRID_BAR();
        { KARGS; pg8::EpiBf16<1> E{(bf16_t*)(ws + OFF_H), 8192}; run_gemm(lds, (const bf16_t*)(ws + OFF_XN), (const bf16_t*)(ws + OFF_WUP), 8192, 2048, E, G, bid); }
#endif
#endif
        GRID_BAR();
#ifndef NO_P9
        if (l + 1 < DEPTH) { KARGS; pg8::EpiResidB<false> E{(const bf16_t*)(ws + OFF_XB), (bf16_t*)(ws + OFF_XB), nullptr, 2048}; run_gemm(lds, (const bf16_t*)(ws + OFF_H), (const bf16_t*)(ws + OFF_WDN), 2048, 8192, E, G, bid); }
        else { KARGS; pg8::EpiResidB<true> E{(const bf16_t*)(ws + OFF_XB), nullptr, ap->out, 2048}; run_gemm(lds, (const bf16_t*)(ws + OFF_H), (const bf16_t*)(ws + OFF_WDN), 2048, 8192, E, G, bid); }
#endif
        if (l + 1 < DEPTH) GRID_BAR();
    }
}

extern "C" void kernel_launch(void* const* d_in, const int* in_sizes, int n_in, void* d_out, int out_size, void* d_ws, size_t ws_size, hipStream_t stream) {
    static int grid = 0;
    if (grid == 0) {
        if (n_in != 21 || in_sizes[0] != T * DM || out_size != T * DM || ws_size < WS_TOTAL) {
            fprintf(stderr, "kernel_launch: unexpected shapes: n_in %d in0 %d out %d ws %zu (need %zu)\n", n_in, n_in > 0 ? in_sizes[0] : -1, out_size, ws_size, (size_t)WS_TOTAL); grid = -1; return; }
        int dev = 0, cus = 0, per_cu = 0;
        if (hipGetDevice(&dev) != hipSuccess || hipDeviceGetAttribute(&cus, hipDeviceAttributeMultiprocessorCount, dev) != hipSuccess) { grid = -1; return; }
        if (hipFuncSetAttribute((const void*)fwd_kernel, hipFuncAttributeMaxDynamicSharedMemorySize, LDS_BYTES) != hipSuccess) { fprintf(stderr, "kernel_launch: hipFuncSetAttribute failed\n"); grid = -1; return; }
        if (hipOccupancyMaxActiveBlocksPerMultiprocessor(&per_cu, (const void*)fwd_kernel, NTHR, LDS_BYTES) != hipSuccess || per_cu < 1) { fprintf(stderr, "kernel_launch: occupancy query says %d\n", per_cu); per_cu = 1; }
        (void)hipGetLastError();
        grid = cus;
    }
    if (grid < 0) return;
    if (hipMemsetAsync((char*)d_ws + OFF_CTL, 0, CTL_BYTES, stream) != hipSuccess) { fprintf(stderr, "kernel_launch: memset failed\n"); return; }
    Args a{};
    const float** pp = (const float**)&a;
    for (int i = 0; i < 21; ++i) pp[i] = (const float*)d_in[i];
    a.out = (float*)d_out; a.ws = (unsigned char*)d_ws;
    void* args[] = {&a};
    hipError_t e = hipLaunchCooperativeKernel((const void*)fwd_kernel, dim3(grid), dim3(NTHR), args, LDS_BYTES, stream);
    if (e != hipSuccess) fprintf(stderr, "kernel_launch: cooperative launch failed: %s (grid %d)\n", hipGetErrorString(e), grid);
}
```

```cpp
#define ATT_PIPE128 1
#define ATT_PVHALF 1
#include <hip/hip_runtime.h>
#include <hip/hip_cooperative_groups.h>
#include <cstdio>
#include <cstdint>
namespace cg = cooperative_groups;
namespace pg8 {
#define PG8_LAS __attribute__((address_space(3)))
typedef unsigned short bf16_t;
typedef short bf16x8 __attribute__((ext_vector_type(8)));
typedef float f32x4 __attribute__((ext_vector_type(4)));
typedef unsigned u32x4 __attribute__((ext_vector_type(4)));
constexpr int BM = 256, BK = 64, HALF = 128, HTB = HALF * BK * 2  , STAGE_BYTES = 8 * HTB, NXCD = 8, WGM = 8;

__host__ __device__ __forceinline__ int lds_byte(int r, int c) { const int st = (r >> 4) * 2 + (c >> 5), rr = r & 15, cc = c & 31, ob = rr * 64 + cc * 2; return st * 1024 + (ob ^ (((ob >> 9) & 1) << 5)); }
__host__ __device__ __forceinline__ void stage_rc(int b, int& R, int& C) { const int st = b / 1024, sb = b % 1024, swz = sb ^ (((sb >> 9) & 1) << 5); R = (st >> 1) * 16 + swz / 64; C = (st & 1) * 32 + (swz % 64) / 2; }
__host__ __device__ __forceinline__ int perm32(int rho) { const int n = rho >> 4, i = rho & 15; return 8 * (i >> 2) + 4 * n + (i & 3); }

struct Unit { int pm, pn; };
struct Gemm { const bf16_t* A; const bf16_t* Bt; int M, N, K; };

struct StaticOrder {
    int nM, nN, nwg, G, c;
    __host__ __device__ void init(int M, int N, int G_, int c_) { nM = M / BM; nN = N / BM; nwg = nM * nN; G = G_; c = c_; }
    __host__ __device__ bool next(int i, Unit& u) const {
        const long L = (long)i * G + c; if (L >= nwg) return false;
        int wgid = (int)L; { const int q = nwg / NXCD, r = nwg % NXCD, xcd = wgid % NXCD, off = wgid / NXCD; wgid = (xcd < r ? xcd * (q + 1) : r * (q + 1) + (xcd - r) * q) + off; }
        const int nig = WGM * nN, gid = wgid / nig, fm = gid * WGM, gsz = (nM - fm) < WGM ? (nM - fm) : WGM;
        u.pm = fm + ((wgid % nig) % gsz); u.pn = (wgid % nig) / gsz; return true;
    }
    __device__ __forceinline__ void a_ready(const Unit&) const {}
    __device__ __forceinline__ void done(const Unit&) const {}
};
typedef float f32x2_cv __attribute__((ext_vector_type(2)));
typedef __bf16 bf16x2_cv __attribute__((ext_vector_type(2)));
__device__ __forceinline__ unsigned cvt_pk_bf16(float lo, float hi) { const f32x2_cv v = {lo, hi}; const bf16x2_cv b = __builtin_convertvector(v, bf16x2_cv); return __builtin_bit_cast(unsigned, b); }
typedef unsigned u32x4 __attribute__((ext_vector_type(4)));
typedef unsigned u32x2 __attribute__((ext_vector_type(2)));
template <int ACT  > struct EpiBf16 {
    static constexpr bool PERM = true, AFTER_DRAIN = false;
    bf16_t* O; int ldc;
    __device__ __forceinline__ void operator()(const f32x4 (&acc)[2][2][4][2], const Unit& u, int wr, int wc, int fr, int fq) const {
        const int row0 = u.pm * BM + wr * 64 + fr, col0 = u.pn * BM + wc * 32 + 8 * fq;
#pragma unroll
        for (int ai = 0; ai < 2; ++ai)
#pragma unroll
            for (int m = 0; m < 4; ++m) { bf16_t* rowp = O + (size_t)(row0 + ai * HALF + m * 16) * ldc + col0;
#pragma unroll
                for (int bj = 0; bj < 2; ++bj) { f32x4 v0 = acc[ai][bj][m][0], v1 = acc[ai][bj][m][1];
                    if (ACT == 1) {
#pragma unroll
                        for (int e = 0; e < 4; ++e) { float a = fmaxf(v0[e], 0.f), b = fmaxf(v1[e], 0.f); v0[e] = a * a; v1[e] = b * b; } }
                    u32x4 w; w.x = cvt_pk_bf16(v0[0], v0[1]); w.y = cvt_pk_bf16(v0[2], v0[3]); w.z = cvt_pk_bf16(v1[0], v1[1]); w.w = cvt_pk_bf16(v1[2], v1[3]);
                    *(u32x4*)(rowp + bj * HALF) = w; } }
    }
};
struct EpiF32 {
    static constexpr bool PERM = false, AFTER_DRAIN = false;
    float* out; int ldc;
    __device__ __forceinline__ void operator()(const f32x4 (&acc)[2][2][4][2], const Unit& u, int wr, int wc, int fr, int fq) const {
        const int row0 = u.pm * BM + wr * 64 + fr, col0 = u.pn * BM + wc * 32 + 4 * fq;
#pragma unroll
        for (int ai = 0; ai < 2; ++ai)
#pragma unroll
            for (int m = 0; m < 4; ++m) { const size_t off = (size_t)(row0 + ai * HALF + m * 16) * ldc + col0;
#pragma unroll
                for (int bj = 0; bj < 2; ++bj)
#pragma unroll
                    for (int n = 0; n < 2; ++n) *(f32x4*)(out + off + bj * HALF + n * 16) = acc[ai][bj][m][n]; }
    }
};
struct EpiResid {
    static constexpr bool PERM = false, AFTER_DRAIN = false;
    const float* base; float* out; int ldc;
    __device__ __forceinline__ void operator()(const f32x4 (&acc)[2][2][4][2], const Unit& u, int wr, int wc, int fr, int fq) const {
        const int row0 = u.pm * BM + wr * 64 + fr, col0 = u.pn * BM + wc * 32 + 4 * fq;
        f32x4 bA[8], bB[8];
#define EPI_LD(dst, g) _Pragma("unroll") for (int q = 0; q < 8; ++q) { const int ai = (g) >> 1, m = ((g) & 1) * 2 + (q >> 2), bj = (q >> 1) & 1, n = q & 1; \
        dst[q] = *(const f32x4*)(base + (size_t)(row0 + ai * HALF + m * 16) * ldc + col0 + bj * HALF + n * 16); }
#define EPI_ST(src, g) _Pragma("unroll") for (int q = 0; q < 8; ++q) { const int ai = (g) >> 1, m = ((g) & 1) * 2 + (q >> 2), bj = (q >> 1) & 1, n = q & 1; \
        *(f32x4*)(out + (size_t)(row0 + ai * HALF + m * 16) * ldc + col0 + bj * HALF + n * 16) = acc[ai][bj][m][n] + src[q]; }
        EPI_LD(bA, 0); EPI_LD(bB, 1); EPI_ST(bA, 0); EPI_LD(bA, 2); EPI_ST(bB, 1); EPI_LD(bB, 3); EPI_ST(bA, 2); EPI_ST(bB, 3);
#undef EPI_LD
#undef EPI_ST
    }
};
struct EpiProj {
    static constexpr bool PERM = true, AFTER_DRAIN = false; static constexpr int VMOPS = 16;
    bf16_t* F; int ldf; int ntf; bf16_t* O; int ldc;
    __device__ __forceinline__ void operator()(const f32x4 (&acc)[2][2][4][2], const Unit& u, int wr, int wc, int fr, int fq) const {
        const int row0 = u.pm * BM + wr * 64 + fr; const bool lat = u.pn < ntf;
        bf16_t* base = lat ? F : O; const int ld = lat ? ldf : ldc; const int col0 = (lat ? u.pn : u.pn - ntf) * BM + wc * 32 + 8 * fq;
#pragma unroll
        for (int ai = 0; ai < 2; ++ai)
#pragma unroll
            for (int m = 0; m < 4; ++m) { bf16_t* rowp = base + (size_t)(row0 + ai * HALF + m * 16) * ld + col0;
#pragma unroll
                for (int bj = 0; bj < 2; ++bj) { const f32x4 v0 = acc[ai][bj][m][0], v1 = acc[ai][bj][m][1];
                    u32x4 w; w.x = cvt_pk_bf16(v0[0], v0[1]); w.y = cvt_pk_bf16(v0[2], v0[3]); w.z = cvt_pk_bf16(v1[0], v1[1]); w.w = cvt_pk_bf16(v1[2], v1[3]);
                    *(u32x4*)(rowp + bj * HALF) = w; } }
    }
};
template <bool TO_F32> struct EpiResidB {
    static constexpr bool PERM = true, AFTER_DRAIN = false; static constexpr int VMOPS = 32;
    const bf16_t* base; bf16_t* outb; float* outf; int ldc;
    __device__ __forceinline__ void operator()(const f32x4 (&acc)[2][2][4][2], const Unit& u, int wr, int wc, int fr, int fq) const {
        const int row0 = u.pm * BM + wr * 64 + fr, col0 = u.pn * BM + wc * 32 + 8 * fq;
        u32x4 bA[4], bB[4];
#define EPI_LD(dst, g) _Pragma("unroll") for (int q = 0; q < 4; ++q) { const int ai = (g) >> 1, m = ((g) & 1) * 2 + (q >> 1), bj = q & 1; \
        dst[q] = *(const u32x4*)(base + (size_t)(row0 + ai * HALF + m * 16) * ldc + col0 + bj * HALF); }
#define EPI_ST(src, g) _Pragma("unroll") for (int q = 0; q < 4; ++q) { const int ai = (g) >> 1, m = ((g) & 1) * 2 + (q >> 1), bj = q & 1; \
        const size_t off = (size_t)(row0 + ai * HALF + m * 16) * ldc + col0 + bj * HALF; const u32x4 b = src[q]; f32x4 v0 = acc[ai][bj][m][0], v1 = acc[ai][bj][m][1]; \
        v0[0] += __uint_as_float(b.x << 16); v0[1] += __uint_as_float(b.x & 0xffff0000u); v0[2] += __uint_as_float(b.y << 16); v0[3] += __uint_as_float(b.y & 0xffff0000u); \
        v1[0] += __uint_as_float(b.z << 16); v1[1] += __uint_as_float(b.z & 0xffff0000u); v1[2] += __uint_as_float(b.w << 16); v1[3] += __uint_as_float(b.w & 0xffff0000u); \
        if constexpr (TO_F32) { *(f32x4*)(outf + off) = v0; *(f32x4*)(outf + off + 4) = v1; } \
        else { u32x4 w; w.x = cvt_pk_bf16(v0[0], v0[1]); w.y = cvt_pk_bf16(v0[2], v0[3]); w.z = cvt_pk_bf16(v1[0], v1[1]); w.w = cvt_pk_bf16(v1[2], v1[3]); *(u32x4*)(outb + off) = w; } }
        EPI_LD(bA, 0); EPI_LD(bB, 1); EPI_ST(bA, 0); EPI_LD(bA, 2); EPI_ST(bB, 1); EPI_LD(bB, 3); EPI_ST(bA, 2); EPI_ST(bB, 3);
#undef EPI_LD
#undef EPI_ST
    }
};
__device__ __forceinline__ float bf_lo(unsigned w) { return __uint_as_float(w << 16); }
__device__ __forceinline__ float bf_hi(unsigned w) { return __uint_as_float(w & 0xffff0000u); }
struct EpiSig {
    static constexpr bool PERM = true, AFTER_DRAIN = false;
    u32x4* S; const float* bias; int nN;
    __device__ __forceinline__ void operator()(const f32x4 (&acc)[2][2][4][2], const Unit& u, int wr, int wc, int fr, int fq) const {
        u32x4* sp = S + (size_t)(u.pm * nN + u.pn) * (16 * 512) + (wr * 4 + wc) * 64 + fq * 16 + fr;
        const int col0 = u.pn * BM + wc * 32 + 8 * fq;
#pragma unroll
        for (int bj = 0; bj < 2; ++bj) { const f32x4 b0 = *(const f32x4*)(bias + col0 + bj * HALF), b1 = *(const f32x4*)(bias + col0 + bj * HALF + 4);
#pragma unroll
            for (int ai = 0; ai < 2; ++ai)
#pragma unroll
                for (int m = 0; m < 4; ++m) { f32x4 v0 = acc[ai][bj][m][0] + b0, v1 = acc[ai][bj][m][1] + b1;
#pragma unroll
                    for (int e = 0; e < 4; ++e) { v0[e] = __builtin_amdgcn_rcpf(1.f + __expf(-v0[e])); v1[e] = __builtin_amdgcn_rcpf(1.f + __expf(-v1[e])); }
                    u32x4 w; w.x = cvt_pk_bf16(v0[0], v0[1]); w.y = cvt_pk_bf16(v0[2], v0[3]); w.z = cvt_pk_bf16(v1[0], v1[1]); w.w = cvt_pk_bf16(v1[2], v1[3]);
                    sp[((ai * 2 + bj) * 4 + m) * 512] = w; } }
    }
};
struct EpiGate {
    static constexpr bool PERM = true, AFTER_DRAIN = false;
    const u32x4* S; u32x4* Mt; bf16_t* O; int ldc; int nN; int mode;
    template <int MODE>
    __device__ __forceinline__ void body(const f32x4 (&acc)[2][2][4][2], const Unit& u, int wr, int wc, int fr, int fq) const {
        const size_t sb = (size_t)(u.pm * nN + u.pn) * (16 * 512) + (wr * 4 + wc) * 64 + fq * 16 + fr;
        const int row0 = u.pm * BM + wr * 64 + fr, col0 = u.pn * BM + wc * 32 + 8 * fq;
        u32x4 sA[2], mA[2], sB[2], mB[2];
#define EPI_LD(sd, md, g) _Pragma("unroll") for (int q = 0; q < 2; ++q) { sd[q] = S[sb + ((g) * 2 + q) * 512]; if constexpr (MODE != 0) md[q] = Mt[sb + ((g) * 2 + q) * 512]; else md[q] = (u32x4){0u, 0u, 0u, 0u}; }
#define EPI_ST(sd, md, g) _Pragma("unroll") for (int q = 0; q < 2; ++q) { const int ai = (g) >> 2, bj = ((g) >> 1) & 1, m = 2 * ((g) & 1) + q; const u32x4 sw = sd[q], ow = md[q]; \
            const f32x4 a0 = acc[ai][bj][m][0], a1 = acc[ai][bj][m][1]; \
            const float v0 = bf_lo(sw.x) * a0[0] + bf_lo(ow.x), v1 = bf_hi(sw.x) * a0[1] + bf_hi(ow.x), v2 = bf_lo(sw.y) * a0[2] + bf_lo(ow.y), v3 = bf_hi(sw.y) * a0[3] + bf_hi(ow.y), \
                        v4 = bf_lo(sw.z) * a1[0] + bf_lo(ow.z), v5 = bf_hi(sw.z) * a1[1] + bf_hi(ow.z), v6 = bf_lo(sw.w) * a1[2] + bf_lo(ow.w), v7 = bf_hi(sw.w) * a1[3] + bf_hi(ow.w); \
            u32x4 w; w.x = cvt_pk_bf16(v0, v1); w.y = cvt_pk_bf16(v2, v3); w.z = cvt_pk_bf16(v4, v5); w.w = cvt_pk_bf16(v6, v7); \
            if constexpr (MODE != 2) Mt[sb + ((g) * 2 + q) * 512] = w; else *(u32x4*)(O + (size_t)(row0 + ai * HALF + m * 16) * ldc + col0 + bj * HALF) = w; }
        EPI_LD(sA, mA, 0); EPI_LD(sB, mB, 1); EPI_ST(sA, mA, 0); EPI_LD(sA, mA, 2); EPI_ST(sB, mB, 1); EPI_LD(sB, mB, 3); EPI_ST(sA, mA, 2); EPI_LD(sA, mA, 4); EPI_ST(sB, mB, 3);
        EPI_LD(sB, mB, 5); EPI_ST(sA, mA, 4); EPI_LD(sA, mA, 6); EPI_ST(sB, mB, 5); EPI_LD(sB, mB, 7); EPI_ST(sA, mA, 6); EPI_ST(sB, mB, 7);
#undef EPI_LD
#undef EPI_ST
    }
    __device__ __forceinline__ void operator()(const f32x4 (&acc)[2][2][4][2], const Unit& u, int wr, int wc, int fr, int fq) const {
        if (mode == 0) body<0>(acc, u, wr, wc, fr, fq); else if (mode == 1) body<1>(acc, u, wr, wc, fr, fq); else body<2>(acc, u, wr, wc, fr, fq);
    }
};
template <class Epi, class Sched, bool ALIGN_EPI = false, bool SP2 = false>
__device__ __forceinline__ void gemm_phase(PG8_LAS unsigned char* lds, const Gemm g, const Sched& S, const Epi& E) {
    int tid_ = threadIdx.x; asm volatile("" : "+v"(tid_));
    const int tid = tid_, wid = __builtin_amdgcn_readfirstlane(tid >> 6), lane = tid & 63, wr = wid >> 2, wc = wid & 3, fr = lane & 15, fq = lane >> 4;
    const int K = g.K, nt = K / BK;
    unsigned voffA[2], voffB[2];
#pragma unroll
    for (int i = 0; i < 2; ++i) { int R, C; stage_rc(tid * 16 + i * 8192, R, C); const int Rb = Epi::PERM ? ((R & ~31) + perm32(R & 31)) : R;
        voffA[i] = (unsigned)(R * K + C) * 2u; voffB[i] = (unsigned)(Rb * K + C) * 2u; }
    const size_t kstep = (size_t)(BK * 2);
    const size_t hstep = (size_t)HALF * K * 2;
    const size_t tstep = 2 * hstep;
    const unsigned ldsw = (unsigned)wid * 1024u;
    const int aoff = lds_byte(wr * 64 + fr, fq * 8), boff = lds_byte(wc * 32 + fr, fq * 8);
#define PG8_SA(b, h) (((b) * 2 + (h)) * HTB)
#define PG8_SB(b, h) ((4 + (b) * 2 + (h)) * HTB)
#define PG8_STAGE(bufoff, gbase, voff) do { _Pragma("unroll") for (int _i = 0; _i < 2; ++_i) \
        __builtin_amdgcn_global_load_lds((const unsigned*)((const char*)(gbase) + (voff)[_i]), (PG8_LAS unsigned*)(lds + (bufoff) + ldsw + _i * 8192), 16, 0, 0); } while (0)
#define PG8_LDA(dst, b, h) do { _Pragma("unroll") for (int m = 0; m < 4; ++m) _Pragma("unroll") for (int k = 0; k < 2; ++k) dst[m][k] = *(const PG8_LAS bf16x8*)(lds + PG8_SA(b, h) + aoff + m * 2048 + k * 1024); } while (0)
#define PG8_LDB(dst, b, h) do { _Pragma("unroll") for (int n = 0; n < 2; ++n) _Pragma("unroll") for (int k = 0; k < 2; ++k) dst[n][k] = *(const PG8_LAS bf16x8*)(lds + PG8_SB(b, h) + boff + n * 2048 + k * 1024); } while (0)
#define PG8_MMA(ai, bj, At, Bt) do { __builtin_amdgcn_s_setprio(1); _Pragma("unroll") for (int m = 0; m < 4; ++m) _Pragma("unroll") for (int n = 0; n < 2; ++n) _Pragma("unroll") for (int k = 0; k < 2; ++k) \
        acc[ai][bj][m][n] = __builtin_amdgcn_mfma_f32_16x16x32_bf16(Bt[n][k], At[m][k], acc[ai][bj][m][n], 0, 0, 0); __builtin_amdgcn_s_setprio(0); } while (0)
#define PG8_WAIT_V(n) asm volatile("s_waitcnt vmcnt(" #n ")" ::: "memory")
#define PG8_WAIT_L(n) asm volatile("s_waitcnt lgkmcnt(" #n ")" ::: "memory")
#define PG8_BAR __builtin_amdgcn_s_barrier()
#define PG8_SCHED __builtin_amdgcn_sched_barrier(0)
    Unit cur, nxt; int ui = 0;
    if (!S.next(0, cur)) return;
    f32x4 acc[2][2][4][2];
#pragma unroll
    for (int a = 0; a < 2; ++a)
#pragma unroll
        for (int b = 0; b < 2; ++b)
#pragma unroll
            for (int m = 0; m < 4; ++m)
#pragma unroll
                for (int n = 0; n < 2; ++n) acc[a][b][m][n] = (f32x4){0.f, 0.f, 0.f, 0.f};
    bf16x8 At[4][2], B0[2][2], B1[2][2];
    const char* cA = (const char*)g.A + (size_t)cur.pm * tstep; const char* cB = (const char*)g.Bt + (size_t)cur.pn * tstep;
    S.a_ready(cur);
    if constexpr (SP2) {
        PG8_STAGE(PG8_SB(0, 0), cB, voffB); PG8_STAGE(PG8_SB(0, 1), cB + hstep, voffB); PG8_STAGE(PG8_SA(0, 0), cA, voffA); PG8_STAGE(PG8_SA(0, 1), cA + hstep, voffA);
        if (wr == 1) PG8_BAR;
        PG8_WAIT_V(2); PG8_BAR;
        PG8_STAGE(PG8_SB(1, 0), cB + kstep, voffB); PG8_STAGE(PG8_SA(1, 0), cA + kstep, voffA); PG8_STAGE(PG8_SB(1, 1), cB + hstep + kstep, voffB);
        PG8_WAIT_V(6); PG8_BAR;
    } else {
        PG8_STAGE(PG8_SB(0, 0), cB, voffB); PG8_STAGE(PG8_SA(0, 0), cA, voffA); PG8_STAGE(PG8_SB(0, 1), cB + hstep, voffB); PG8_STAGE(PG8_SA(0, 1), cA + hstep, voffA);
        if (wr == 1) PG8_BAR;
        PG8_WAIT_V(4); PG8_BAR;
        PG8_STAGE(PG8_SB(1, 0), cB + kstep, voffB); PG8_STAGE(PG8_SA(1, 0), cA + kstep, voffA); PG8_STAGE(PG8_SB(1, 1), cB + hstep + kstep, voffB);
        PG8_WAIT_V(6); PG8_BAR;
    }
    for (;;) {
        const bool has_next = S.next(ui + 1, nxt);
        const char* nA = has_next ? (const char*)g.A + (size_t)nxt.pm * tstep : cA; const char* nB = has_next ? (const char*)g.Bt + (size_t)nxt.pn * tstep : cB;
        for (int t = 0; t < nt; t += 2) {
            const bool last = (t == nt - 2);
            const char* a1 = cA + (size_t)(t + 1) * kstep;
            const char* a2 = last ? nA : cA + (size_t)(t + 2) * kstep; const char* b2 = last ? nB : cB + (size_t)(t + 2) * kstep;
            const char* a3 = a2 + kstep; const char* b3 = b2 + kstep;
            if (last && has_next) S.a_ready(nxt);
            if constexpr (SP2) {
            PG8_LDB(B0, 0, 0); PG8_LDB(B1, 0, 1); PG8_SCHED; PG8_LDA(At, 0, 0); PG8_STAGE(PG8_SA(1, 1), a1 + hstep, voffA);
            PG8_WAIT_V(8); PG8_WAIT_L(0); PG8_BAR; PG8_MMA(0, 0, At, B0); PG8_MMA(0, 1, At, B1); PG8_BAR; PG8_SCHED;
            PG8_LDA(At, 0, 1); PG8_STAGE(PG8_SB(0, 0), b2, voffB); PG8_STAGE(PG8_SB(0, 1), b2 + hstep, voffB); PG8_STAGE(PG8_SA(0, 0), a2, voffA);
            PG8_WAIT_V(8); PG8_WAIT_L(0); PG8_BAR; PG8_MMA(1, 0, At, B0); PG8_MMA(1, 1, At, B1); PG8_BAR; PG8_SCHED;
            PG8_LDB(B0, 1, 0); PG8_LDB(B1, 1, 1); PG8_SCHED; PG8_LDA(At, 1, 0); PG8_STAGE(PG8_SA(0, 1), a2 + hstep, voffA);
            PG8_WAIT_V(8); PG8_WAIT_L(0); PG8_BAR; PG8_MMA(0, 0, At, B0); PG8_MMA(0, 1, At, B1); PG8_BAR; PG8_SCHED;
            PG8_LDA(At, 1, 1); PG8_STAGE(PG8_SB(1, 0), b3, voffB); PG8_STAGE(PG8_SB(1, 1), b3 + hstep, voffB); PG8_STAGE(PG8_SA(1, 0), a3, voffA);
            PG8_WAIT_V(8); PG8_WAIT_L(0); PG8_BAR; PG8_MMA(1, 0, At, B0); PG8_MMA(1, 1, At, B1); PG8_BAR; PG8_SCHED;
            } else {
            PG8_LDB(B0, 0, 0); PG8_SCHED; PG8_LDA(At, 0, 0); PG8_STAGE(PG8_SA(1, 1), a1 + hstep, voffA);
            PG8_WAIT_L(8); PG8_BAR; PG8_WAIT_L(0); PG8_MMA(0, 0, At, B0); PG8_BAR; PG8_SCHED;
            PG8_LDB(B1, 0, 1); PG8_STAGE(PG8_SB(0, 0), b2, voffB);
            PG8_BAR; PG8_WAIT_L(0); PG8_MMA(0, 1, At, B1); PG8_BAR;
            PG8_LDA(At, 0, 1); PG8_STAGE(PG8_SA(0, 0), a2, voffA);
            PG8_BAR; PG8_WAIT_L(0); PG8_MMA(1, 0, At, B0); PG8_BAR; PG8_SCHED;
            PG8_STAGE(PG8_SB(0, 1), b2 + hstep, voffB);
            PG8_WAIT_V(6); PG8_BAR; PG8_MMA(1, 1, At, B1); PG8_BAR;
            PG8_LDB(B0, 1, 0); PG8_SCHED; PG8_LDA(At, 1, 0); PG8_STAGE(PG8_SA(0, 1), a2 + hstep, voffA);
            PG8_WAIT_L(8); PG8_BAR; PG8_WAIT_L(0); PG8_MMA(0, 0, At, B0); PG8_BAR; PG8_SCHED;
            PG8_LDB(B1, 1, 1); PG8_STAGE(PG8_SB(1, 0), b3, voffB);
            PG8_BAR; PG8_WAIT_L(0); PG8_MMA(0, 1, At, B1); PG8_BAR;
            PG8_LDA(At, 1, 1); PG8_STAGE(PG8_SA(1, 0), a3, voffA);
            PG8_BAR; PG8_WAIT_L(0); PG8_MMA(1, 0, At, B0); PG8_BAR; PG8_SCHED;
            PG8_STAGE(PG8_SB(1, 1), b3 + hstep, voffB);
            PG8_WAIT_V(6); PG8_BAR; PG8_MMA(1, 1, At, B1); PG8_BAR;
            }
        }
        if constexpr (ALIGN_EPI) { if (wr == 0) PG8_BAR; }
        if constexpr (!Epi::AFTER_DRAIN) { E(acc, cur, wr, wc, fr, fq); S.done(cur); }
        if (!has_next) break;
#pragma unroll
        for (int a = 0; a < 2; ++a)
#pragma unroll
            for (int b = 0; b < 2; ++b)
#pragma unroll
                for (int m = 0; m < 4; ++m)
#pragma unroll
                    for (int n = 0; n < 2; ++n) acc[a][b][m][n] = (f32x4){0.f, 0.f, 0.f, 0.f};
        cur = nxt; cA = nA; cB = nB; ++ui;
        if constexpr (ALIGN_EPI) { if (wr == 1) PG8_BAR; }
    }
    PG8_WAIT_V(0);
    if constexpr (!ALIGN_EPI) { if (wr == 0) PG8_BAR; }
    PG8_BAR;
    if constexpr (Epi::AFTER_DRAIN) { E.fused(acc, cur, wr, wc, fr, fq, lds, wid, lane); S.done(cur); }
#undef PG8_SA
#undef PG8_SB
#undef PG8_STAGE
#undef PG8_LDA
#undef PG8_LDB
#undef PG8_MMA
#undef PG8_WAIT_V
#undef PG8_WAIT_L
#undef PG8_BAR
#undef PG8_SCHED
}
}
namespace att {
typedef unsigned short bf16_t;
typedef short bf16x8 __attribute__((ext_vector_type(8)));
typedef short s16x4 __attribute__((ext_vector_type(4)));
typedef float f32x16 __attribute__((ext_vector_type(16)));
typedef unsigned u32x4 __attribute__((ext_vector_type(4)));
constexpr float THR = 8.f;
#define SBAR() __builtin_amdgcn_sched_barrier(0)
__device__ __forceinline__ int crow(int r, int hi) { return (r & 3) + 8 * (r >> 2) + 4 * hi; }
__device__ __forceinline__ unsigned cvtpk(float lo, float hi) { return pg8::cvt_pk_bf16(lo, hi); }

struct Unit { const bf16_t* Q; const bf16_t* K; const bf16_t* V; bf16_t* O; float* LSE; int ldq, ldk, ldv, ldo, ldlse; int q0, L, kt0, kt1, R; };

template <int DK> struct Cfg { static constexpr float SCALE = (DK == 128) ? 0.08838834764831845f : 0.07216878364870323f; };

template <int DK>
__device__ __forceinline__ void partialSM(f32x16& p0, f32x16& p1, float& m_reg, float& mn, float& alpha) {
  constexpr float SCALE = Cfg<DK>::SCALE, C = SCALE * 1.4426950408889634f;
  float pmax = p0[0];
#pragma unroll
  for (int r = 1; r < 16; ++r) pmax = fmaxf(pmax, p0[r]);
#pragma unroll
  for (int r = 0; r < 16; ++r) pmax = fmaxf(pmax, p1[r]);
  { auto rr = __builtin_amdgcn_permlane32_swap(__float_as_uint(pmax), __float_as_uint(pmax), false, false);
    pmax = fmaxf(__uint_as_float(rr[0]), __uint_as_float(rr[1])); }
  if (__builtin_expect(__all(pmax - m_reg <= THR / SCALE), 1)) { mn = m_reg; alpha = 1.f; }
  else { mn = fmaxf(m_reg, pmax); alpha = __builtin_amdgcn_exp2f((m_reg - mn) * C); m_reg = mn; }
  const float mnC = -mn * C;
#pragma unroll
  for (int r = 0; r < 16; ++r) p0[r] = fmaf(p0[r], C, mnC);
#pragma unroll
  for (int r = 0; r < 16; ++r) p1[r] = fmaf(p1[r], C, mnC);
#pragma unroll
  for (int r = 0; r < 16; ++r) p0[r] = __builtin_amdgcn_exp2f(p0[r]);
}
__device__ __forceinline__ void finishSM(f32x16& p0, f32x16& p1, float alpha, float& l_reg, bf16x8& pa0, bf16x8& pa1, bf16x8& pa2, bf16x8& pa3) {
#pragma unroll
  for (int r = 0; r < 16; ++r) p1[r] = __builtin_amdgcn_exp2f(p1[r]);
  float ps = 0;
#pragma unroll
  for (int r = 0; r < 16; ++r) ps += p0[r];
#pragma unroll
  for (int r = 0; r < 16; ++r) ps += p1[r];
  { auto rr = __builtin_amdgcn_permlane32_swap(__float_as_uint(ps), __float_as_uint(ps), false, false);
    ps = __uint_as_float(rr[0]) + __uint_as_float(rr[1]); }
  l_reg = l_reg * alpha + ps;
#define PK4(P, BASE, OUT) do { unsigned a0 = cvtpk(P[BASE + 0], P[BASE + 1]), a1 = cvtpk(P[BASE + 2], P[BASE + 3]);   \
    unsigned b0 = cvtpk(P[BASE + 4], P[BASE + 5]), b1 = cvtpk(P[BASE + 6], P[BASE + 7]);                              \
    auto r0 = __builtin_amdgcn_permlane32_swap(a0, b0, false, false); auto r1 = __builtin_amdgcn_permlane32_swap(a1, b1, false, false); \
    u32x4 w = {r0[0], r1[0], r0[1], r1[1]}; OUT = *reinterpret_cast<bf16x8*>(&w); } while (0)
  PK4(p0, 0, pa0); PK4(p0, 8, pa1); PK4(p1, 0, pa2); PK4(p1, 8, pa3);
#undef PK4
}
__device__ __forceinline__ int v_st(int k, int c) { const int kk = (k & ~0xC) | ((k & 4) << 1) | ((k & 8) >> 1); return ((kk >> 3) * 4 + (c >> 5)) * 512 + ((kk & 7) * 32 + (c & 31)) * 2; }
__device__ __forceinline__ int v_rd_base(int lane) { return ((lane & 3) << 3) | (((lane >> 2) & 3) << 6) | (((lane >> 4) & 1) << 5) | (((lane >> 5) & 1) << 8); }
constexpr int v_rd_off(int d0, int ks, int half) { return d0 * 512 + ks * 4096 + half * 2048; }
template <int OFF> __device__ __forceinline__ s16x4 tr_read(int vb) {
  s16x4 r; asm volatile("ds_read_b64_tr_b16 %0, %1 offset:%2" : "=&v"(r) : "v"(vb), "i"(OFF) : "memory"); return r;
}
template <int D0> __device__ __forceinline__ void pv_one(f32x16& od, int vb, bf16x8 pa0, bf16x8 pa1, bf16x8 pa2, bf16x8 pa3) {
  const s16x4 l0 = tr_read<v_rd_off(D0, 0, 0)>(vb), h0 = tr_read<v_rd_off(D0, 0, 1)>(vb), l1 = tr_read<v_rd_off(D0, 1, 0)>(vb), h1 = tr_read<v_rd_off(D0, 1, 1)>(vb);
  const s16x4 l2 = tr_read<v_rd_off(D0, 2, 0)>(vb), h2 = tr_read<v_rd_off(D0, 2, 1)>(vb), l3 = tr_read<v_rd_off(D0, 3, 0)>(vb), h3 = tr_read<v_rd_off(D0, 3, 1)>(vb);
  asm volatile("s_waitcnt lgkmcnt(0)" ::: "memory"); SBAR();
#define PK(L, H) (bf16x8){L[0], L[1], L[2], L[3], H[0], H[1], H[2], H[3]}
  od = __builtin_amdgcn_mfma_f32_32x32x16_bf16(pa0, PK(l0, h0), od, 0, 0, 0);
  od = __builtin_amdgcn_mfma_f32_32x32x16_bf16(pa1, PK(l1, h1), od, 0, 0, 0);
  od = __builtin_amdgcn_mfma_f32_32x32x16_bf16(pa2, PK(l2, h2), od, 0, 0, 0);
  od = __builtin_amdgcn_mfma_f32_32x32x16_bf16(pa3, PK(l3, h3), od, 0, 0, 0);
#undef PK
}

template <int D0> __device__ __forceinline__ void pv_half(f32x16& od, int vb, bf16x8 pa0, bf16x8 pa1, bf16x8 pa2, bf16x8 pa3) {
#define PK(L, H) (bf16x8){L[0], L[1], L[2], L[3], H[0], H[1], H[2], H[3]}
  { const s16x4 l0 = tr_read<v_rd_off(D0, 0, 0)>(vb), h0 = tr_read<v_rd_off(D0, 0, 1)>(vb), l1 = tr_read<v_rd_off(D0, 1, 0)>(vb), h1 = tr_read<v_rd_off(D0, 1, 1)>(vb);
    asm volatile("s_waitcnt lgkmcnt(0)" ::: "memory"); SBAR();
    od = __builtin_amdgcn_mfma_f32_32x32x16_bf16(pa0, PK(l0, h0), od, 0, 0, 0);
    od = __builtin_amdgcn_mfma_f32_32x32x16_bf16(pa1, PK(l1, h1), od, 0, 0, 0); }
  { const s16x4 l2 = tr_read<v_rd_off(D0, 2, 0)>(vb), h2 = tr_read<v_rd_off(D0, 2, 1)>(vb), l3 = tr_read<v_rd_off(D0, 3, 0)>(vb), h3 = tr_read<v_rd_off(D0, 3, 1)>(vb);
    asm volatile("s_waitcnt lgkmcnt(0)" ::: "memory"); SBAR();
    od = __builtin_amdgcn_mfma_f32_32x32x16_bf16(pa2, PK(l2, h2), od, 0, 0, 0);
    od = __builtin_amdgcn_mfma_f32_32x32x16_bf16(pa3, PK(l3, h3), od, 0, 0, 0); }
#undef PK
}

__device__ __forceinline__ void store_o_tile(const f32x16 (&o)[4], const float* li_l, const Unit& u, char* lds, int wid, int lane, int r32, int hi) {
  float rl[16];
#pragma unroll
  for (int r = 0; r < 16; ++r) rl[r] = __builtin_amdgcn_rcpf(li_l[crow(r, hi)]);
  asm volatile("s_waitcnt lgkmcnt(0)" ::: "memory");
  __syncthreads();
  char* img = lds + wid * (32 * 272);
#pragma unroll
  for (int r = 0; r < 16; ++r) { const int orow = crow(r, hi);
#pragma unroll
    for (int d0 = 0; d0 < 4; ++d0) *(bf16_t*)(img + orow * 272 + (d0 * 32 + r32) * 2) = (bf16_t)(cvtpk(o[d0][r] * rl[r], 0.f) & 0xffffu); }
  asm volatile("s_waitcnt lgkmcnt(0)" ::: "memory");
  const int row_base = u.q0 + wid * 32;
  bf16_t* Ow = u.O + (size_t)row_base * u.ldo;
#pragma unroll
  for (int i = 0; i < 8; ++i) { const int ch = lane + 64 * i, r = ch >> 4, cc = ch & 15;
    const u32x4 v = *(const u32x4*)(img + r * 272 + cc * 16);
    if (row_base + r < u.L) *(u32x4*)(Ow + (size_t)r * u.ldo + cc * 8) = v; }
  __syncthreads();
}

template <int DK>
__device__ __forceinline__ void attn_unit(const Unit& u, char* lds) {
  constexpr int ND0 = DK / 16, NCK = DK / 8, NKI = DK / 64, KROWB = DK * 2;
  constexpr int SHM_V = 16384, SHM_K = 64 * KROWB;
  constexpr float SCALE = Cfg<DK>::SCALE;
#define KSWZ(row, colB) ((row) * KROWB + ((colB) ^ (((row) & 7) << 4)))
  int tid_ = threadIdx.x; asm volatile("" : "+v"(tid_));
  const int tid = tid_, wid = tid >> 6, lane = tid & 63, r32 = lane & 31, hi = lane >> 5;
  char* V_lds = lds; char* K_lds = lds + 2 * SHM_V;
  float* wsf = (float*)(lds + 2 * SHM_V + 2 * SHM_K) + wid * 64; float* li_l = wsf; float* al_l = wsf + 32;
  float m_reg = -1e30f, l_reg = 0.f; f32x16 o[4] = {}; bf16x8 qr[ND0];
  const int qrow = u.q0 + wid * 32 + r32;
  { const int qc = qrow < u.L ? qrow : u.L - 1;
    const bf16_t* Qw = u.Q + (size_t)qc * u.ldq + hi * 8;
#pragma unroll
    for (int d0 = 0; d0 < ND0; ++d0) qr[d0] = *reinterpret_cast<const bf16x8*>(Qw + d0 * 16); }
  const int sr = tid >> 4, sc = (tid & 15) * 8;
  const int vst0 = v_st(sr, sc), vst1 = v_st(32 + sr, sc);
  const unsigned voffV0 = (unsigned)(sr * u.ldv + sc) * 2u, voffV1 = (unsigned)((sr + 32) * u.ldv + sc) * 2u;
  unsigned voffK[NKI]; int kst[NKI];
#pragma unroll
  for (int i = 0; i < NKI; ++i) { const int c = tid + 512 * i, row = c / NCK, cc = c % NCK; voffK[i] = (unsigned)(row * u.ldk + cc * 8) * 2u; kst[i] = KSWZ(row, cc * 16); }
  const int vb0 = (int)(uintptr_t)V_lds + v_rd_base(lane);
  bf16x8 vs0, vs1, ks[NKI];
#define SLOAD(kt) do { const char* vb_ = (const char*)u.V + (size_t)(kt) * 64 * u.ldv * 2; const char* kb_ = (const char*)u.K + (size_t)(kt) * 64 * u.ldk * 2; \
    vs0 = *(const bf16x8*)(vb_ + voffV0); vs1 = *(const bf16x8*)(vb_ + voffV1); \
    _Pragma("unroll") for (int i_ = 0; i_ < NKI; ++i_) ks[i_] = *(const bf16x8*)(kb_ + voffK[i_]); } while (0)
#define SWRITE(b) do { *(bf16x8*)(V_lds + (b) * SHM_V + vst0) = vs0; *(bf16x8*)(V_lds + (b) * SHM_V + vst1) = vs1; \
    _Pragma("unroll") for (int i_ = 0; i_ < NKI; ++i_) *(bf16x8*)(K_lds + (b) * SHM_K + kst[i_]) = ks[i_]; } while (0)
  const bool masked = u.R < u.L;
  SLOAD(u.kt0); SWRITE(0); __syncthreads();
  for (int j = u.kt0; j < u.kt1; ++j) {
    const int b = (j - u.kt0) & 1; const bool more = (j + 1 < u.kt1);
    if (more) SLOAD(j + 1);
    f32x16 p0 = {}, p1 = {};
    { const char* Ks = K_lds + b * SHM_K; __builtin_amdgcn_s_setprio(1);
#pragma unroll
      for (int d0 = 0; d0 < ND0; ++d0) { const int cb = (d0 * 16 + hi * 8) * 2;
        const bf16x8 b0 = *reinterpret_cast<const bf16x8*>(Ks + KSWZ(r32, cb));
        const bf16x8 b1 = *reinterpret_cast<const bf16x8*>(Ks + KSWZ(32 + r32, cb));
        p0 = __builtin_amdgcn_mfma_f32_32x32x16_bf16(b0, qr[d0], p0, 0, 0, 0);
        p1 = __builtin_amdgcn_mfma_f32_32x32x16_bf16(b1, qr[d0], p1, 0, 0, 0); } __builtin_amdgcn_s_setprio(0); }
    if (masked) { const int d = qrow - j * 64 - 4 * hi, R = u.R;
#pragma unroll
      for (int r = 0; r < 16; ++r) { const int dl = d - ((r & 3) + 8 * (r >> 2));
        if (dl > R || dl < -R) p0[r] = -1e30f;
        if (dl - 32 > R || dl - 32 < -R) p1[r] = -1e30f; } }
    float mn, alpha; partialSM<DK>(p0, p1, m_reg, mn, alpha);
    if (__any(alpha < 1.f)) { if (hi == 0) al_l[r32] = alpha; asm volatile("s_waitcnt lgkmcnt(0)" ::: "memory");
#pragma unroll
      for (int dd = 0; dd < 4; ++dd)
#pragma unroll
        for (int r = 0; r < 16; ++r) o[dd][r] *= al_l[crow(r, hi)]; }
    bf16x8 pa0, pa1, pa2, pa3; finishSM(p0, p1, alpha, l_reg, pa0, pa1, pa2, pa3); SBAR();
    { const int vb = vb0 + b * SHM_V; __builtin_amdgcn_s_setprio(1);
      pv_one<0>(o[0], vb, pa0, pa1, pa2, pa3); pv_one<1>(o[1], vb, pa0, pa1, pa2, pa3); pv_one<2>(o[2], vb, pa0, pa1, pa2, pa3); pv_one<3>(o[3], vb, pa0, pa1, pa2, pa3); __builtin_amdgcn_s_setprio(0); }
    if (more) SWRITE(b ^ 1);
    __syncthreads();
  }
  if (hi == 0) li_l[r32] = l_reg; asm volatile("s_waitcnt lgkmcnt(0)" ::: "memory");
  if (u.LSE && hi == 0 && qrow < u.L) u.LSE[(size_t)qrow * u.ldlse] = m_reg * SCALE + logf(l_reg);
  store_o_tile(o, li_l, u, lds, wid, lane, r32, hi);
#undef SLOAD
#undef SWRITE
#undef KSWZ
}

template <int DK>
__device__ __forceinline__ void attn_unit_pipe(const Unit& u, char* lds) {
  constexpr int ND0 = DK / 16, NCK = DK / 8, NKI = DK / 64, KROWB = DK * 2;
  constexpr int SHM_V = 16384, SHM_K = 64 * KROWB;
  constexpr float SCALE = Cfg<DK>::SCALE;
#define KSWZ(row, colB) ((row) * KROWB + ((colB) ^ (((row) & 7) << 4)))
  int tid_ = threadIdx.x; asm volatile("" : "+v"(tid_));
  const int tid = tid_, wid = tid >> 6, lane = tid & 63, r32 = lane & 31, hi = lane >> 5;
  char* V_lds = lds; char* K_lds = lds + 2 * SHM_V;
  float* wsf = (float*)(lds + 2 * SHM_V + 2 * SHM_K) + wid * 64; float* li_l = wsf; float* al_l = wsf + 32;
  float m_reg = -1e30f, l_reg = 0.f; f32x16 o[4] = {}; bf16x8 qr[ND0];
  const int qrow = u.q0 + wid * 32 + r32;
  { const int qc = qrow < u.L ? qrow : u.L - 1;
    const bf16_t* Qw = u.Q + (size_t)qc * u.ldq + hi * 8;
#pragma unroll
    for (int d0 = 0; d0 < ND0; ++d0) qr[d0] = *reinterpret_cast<const bf16x8*>(Qw + d0 * 16); }
  const int sr = tid >> 4, sc = (tid & 15) * 8;
  const int vst0 = v_st(sr, sc), vst1 = v_st(32 + sr, sc);
  const unsigned voffV0 = (unsigned)(sr * u.ldv + sc) * 2u, voffV1 = (unsigned)((sr + 32) * u.ldv + sc) * 2u;
  unsigned voffK[NKI]; int kst[NKI];
#pragma unroll
  for (int i = 0; i < NKI; ++i) { const int c = tid + 512 * i, row = c / NCK, cc = c % NCK; voffK[i] = (unsigned)(row * u.ldk + cc * 8) * 2u; kst[i] = KSWZ(row, cc * 16); }
  const int vb0 = (int)(uintptr_t)V_lds + v_rd_base(lane);
  bf16x8 vs0, vs1, ks[NKI];
#define SLOAD(kt) do { const char* vb_ = (const char*)u.V + (size_t)(kt) * 64 * u.ldv * 2; const char* kb_ = (const char*)u.K + (size_t)(kt) * 64 * u.ldk * 2; \
    vs0 = *(const bf16x8*)(vb_ + voffV0); vs1 = *(const bf16x8*)(vb_ + voffV1); \
    _Pragma("unroll") for (int i_ = 0; i_ < NKI; ++i_) ks[i_] = *(const bf16x8*)(kb_ + voffK[i_]); } while (0)
#define SWRITE(b) do { *(bf16x8*)(V_lds + (b) * SHM_V + vst0) = vs0; *(bf16x8*)(V_lds + (b) * SHM_V + vst1) = vs1; \
    _Pragma("unroll") for (int i_ = 0; i_ < NKI; ++i_) *(bf16x8*)(K_lds + (b) * SHM_K + kst[i_]) = ks[i_]; } while (0)
#define QKT(P0, P1, b) do { P0 = f32x16{}; P1 = f32x16{}; const char* Ks = K_lds + (b) * SHM_K; \
    _Pragma("unroll") for (int d0 = 0; d0 < ND0; ++d0) { const int cb = (d0 * 16 + hi * 8) * 2; \
      const bf16x8 b0 = *reinterpret_cast<const bf16x8*>(Ks + KSWZ(r32, cb)); const bf16x8 b1 = *reinterpret_cast<const bf16x8*>(Ks + KSWZ(32 + r32, cb)); \
      P0 = __builtin_amdgcn_mfma_f32_32x32x16_bf16(b0, qr[d0], P0, 0, 0, 0); P1 = __builtin_amdgcn_mfma_f32_32x32x16_bf16(b1, qr[d0], P1, 0, 0, 0); } } while (0)
#define MASK(P0, P1, kt) do { if (masked) { const int d_ = qrow - (kt) * 64 - 4 * hi, R_ = u.R; \
    _Pragma("unroll") for (int r = 0; r < 16; ++r) { const int dl = d_ - ((r & 3) + 8 * (r >> 2)); \
      if (dl > R_ || dl < -R_) P0[r] = -1e30f; if (dl - 32 > R_ || dl - 32 < -R_) P1[r] = -1e30f; } } } while (0)
#define RESC(a) do { if (__any((a) < 1.f)) { if (hi == 0) al_l[r32] = (a); asm volatile("s_waitcnt lgkmcnt(0)" ::: "memory"); \
    _Pragma("unroll") for (int dd = 0; dd < 4; ++dd) _Pragma("unroll") for (int r = 0; r < 16; ++r) o[dd][r] *= al_l[crow(r, hi)]; } } while (0)
#ifdef ATT_PVHALF
#define PV(b) do { const int vb = vb0 + (b) * SHM_V; pv_half<0>(o[0], vb, pa0, pa1, pa2, pa3); pv_half<1>(o[1], vb, pa0, pa1, pa2, pa3); pv_half<2>(o[2], vb, pa0, pa1, pa2, pa3); pv_half<3>(o[3], vb, pa0, pa1, pa2, pa3); } while (0)
#else
#define PV(b) do { const int vb = vb0 + (b) * SHM_V; pv_one<0>(o[0], vb, pa0, pa1, pa2, pa3); pv_one<1>(o[1], vb, pa0, pa1, pa2, pa3); pv_one<2>(o[2], vb, pa0, pa1, pa2, pa3); pv_one<3>(o[3], vb, pa0, pa1, pa2, pa3); } while (0)
#endif
  const bool masked = u.R < u.L;
  const int NT = u.kt1 - u.kt0, k0 = u.kt0;
  f32x16 pA0, pA1, pB0, pB1; float mnA, mnB, alA, alB; bf16x8 pa0, pa1, pa2, pa3;
  SLOAD(k0); SWRITE(0); __syncthreads();
  QKT(pA0, pA1, 0); MASK(pA0, pA1, k0); partialSM<DK>(pA0, pA1, m_reg, mnA, alA);
  SLOAD(k0 + 1); SWRITE(1); __syncthreads();
  for (int j = 1; j + 1 < NT; j += 2) {
    SBAR(); QKT(pB0, pB1, 1); MASK(pB0, pB1, k0 + j);
    finishSM(pA0, pA1, alA, l_reg, pa0, pa1, pa2, pa3); SBAR();
    SLOAD(k0 + j + 1); SBAR();
    PV(0); partialSM<DK>(pB0, pB1, m_reg, mnB, alB);
    __syncthreads(); SWRITE(0);
    RESC(alB); __syncthreads();
    SBAR(); QKT(pA0, pA1, 0); MASK(pA0, pA1, k0 + j + 1);
    finishSM(pB0, pB1, alB, l_reg, pa0, pa1, pa2, pa3); SBAR();
    SLOAD(k0 + j + 2); SBAR();
    PV(1); partialSM<DK>(pA0, pA1, m_reg, mnA, alA);
    __syncthreads(); SWRITE(1);
    RESC(alA); __syncthreads();
  }
  SBAR(); QKT(pB0, pB1, 1); MASK(pB0, pB1, k0 + NT - 1);
  finishSM(pA0, pA1, alA, l_reg, pa0, pa1, pa2, pa3); SBAR();
  PV(0); partialSM<DK>(pB0, pB1, m_reg, mnB, alB);
  RESC(alB);
  finishSM(pB0, pB1, alB, l_reg, pa0, pa1, pa2, pa3); SBAR();
  PV(1);
  if (hi == 0) li_l[r32] = l_reg; asm volatile("s_waitcnt lgkmcnt(0)" ::: "memory");
  if (u.LSE && hi == 0 && qrow < u.L) u.LSE[(size_t)qrow * u.ldlse] = m_reg * SCALE + logf(l_reg);
  store_o_tile(o, li_l, u, lds, wid, lane, r32, hi);
#undef SLOAD
#undef SWRITE
#undef QKT
#undef MASK
#undef RESC
#undef PV
#undef KSWZ
}
}
#define LAS __attribute__((address_space(3)))
#define XB_TMO      128
#define XB_XCNT(j)  (256  + 64 * (j))
#define XB_XSUB(j)  (1280 + 64 * (j))
#define XB_XGEN(j)  (2304 + 64 * (j))
#define XB_TOP      3328
#define XB_TOPGEN   3392
#define XCD_BAR_WORDS 3456
#define XB_SPIN_CAP (1u << 18)

__device__ __forceinline__ unsigned xb_ld(unsigned* p)              { return __hip_atomic_load(p, __ATOMIC_RELAXED, __HIP_MEMORY_SCOPE_AGENT); }
__device__ __forceinline__ unsigned xb_add(unsigned* p, unsigned v) { return __hip_atomic_fetch_add(p, v, __ATOMIC_RELAXED, __HIP_MEMORY_SCOPE_AGENT); }
__device__ __forceinline__ unsigned xb_xcc_id() { return (unsigned)__builtin_amdgcn_s_getreg((3 << 11) | 20) & 0xFu; }
#define XB_SPIN(cond, bar) do { unsigned _sp = 0; while (cond) { __builtin_amdgcn_s_sleep(1); \
    if ((++_sp & 255u) == 0u) { if (xb_ld(&(bar)[XB_TMO])) break; if (_sp > XB_SPIN_CAP) { atomicAdd(&(bar)[XB_TMO], 1u); break; } } } } while (0)

struct XcdBarrier {
    unsigned* bar; unsigned x;
    volatile LAS unsigned* st;
};

__device__ __forceinline__ XcdBarrier xcd_barrier_post(unsigned* bar, volatile LAS unsigned* st) {
    XcdBarrier b; b.bar = bar; b.x = xb_xcc_id(); b.st = st;
    if (threadIdx.x == 0) (void)xb_add(&bar[XB_XCNT(b.x)], 1u);
    return b;
}
__device__ __forceinline__ void xcd_barrier_complete(unsigned* bar, unsigned x, unsigned& nloc, unsigned& nx) {
    const unsigned G = gridDim.x * gridDim.y * gridDim.z;
    unsigned sum, cnt, mine, sp = 0u;
    for (;;) {
        sum = 0u; cnt = 0u; mine = 0u;
#pragma unroll
        for (unsigned j = 0; j < 16; ++j) { const unsigned c = xb_ld(&bar[XB_XCNT(j)]); sum += c; cnt += (c > 0u) ? 1u : 0u; mine = (j == x) ? c : mine; }
        if (sum == G) break;
        __builtin_amdgcn_s_sleep(1);
        if ((++sp & 255u) == 0u) { if (xb_ld(&bar[XB_TMO])) break; if (sp > XB_SPIN_CAP) { atomicAdd(&bar[XB_TMO], 1u); break; } }
    }
    nloc = mine > 0u ? mine : 1u; nx = cnt > 0u ? cnt : 1u;
}

__device__ __forceinline__ void xcd_barrier(const XcdBarrier& b) {
    asm volatile("s_waitcnt vmcnt(0)" ::: "memory");
    __syncthreads();
    if (threadIdx.x == 0) {
        unsigned* bar = b.bar;
        __builtin_amdgcn_s_waitcnt(0);
        unsigned nloc = b.st[0], nx = b.st[1];
        if (nloc == 0u) { xcd_barrier_complete(bar, b.x, nloc, nx); b.st[0] = nloc; b.st[1] = nx; }
        const unsigned old = xb_add(&bar[XB_XSUB(b.x)], 1u);
        const unsigned gen = old / nloc;
        if (old + 1u == (gen + 1u) * nloc) {
            __builtin_amdgcn_fence(__ATOMIC_RELEASE, "agent");
            asm volatile("s_waitcnt vmcnt(0)" ::: "memory");
            const unsigned og = xb_add(&bar[XB_TOP], 1u);
            const unsigned tg = og / nx;
            if (og + 1u == (tg + 1u) * nx) xb_add(&bar[XB_TOPGEN], 1u);
            else XB_SPIN(xb_ld(&bar[XB_TOPGEN]) == tg, bar);
            __builtin_amdgcn_fence(__ATOMIC_ACQUIRE, "agent");
            xb_add(&bar[XB_XGEN(b.x)], 1u);
            asm volatile("s_waitcnt vmcnt(0)" ::: "memory");
        } else {
            XB_SPIN(xb_ld(&bar[XB_XGEN(b.x)]) == gen, bar);
            __builtin_amdgcn_fence(__ATOMIC_ACQUIRE, "agent");
            asm volatile("s_waitcnt vmcnt(0)" ::: "memory");
        }
    }
    __syncthreads();
}
typedef unsigned short bf16_t;
typedef float f32x4 __attribute__((ext_vector_type(4)));
typedef unsigned u32x4 __attribute__((ext_vector_type(4)));
typedef unsigned u32x2 __attribute__((ext_vector_type(2)));
constexpr int NWAVES = 8, NTHR = 512;
constexpr int LDS_BYTES = 135168;
constexpr int T = 16384, SEQ = 2048, DM = 2048, DEPTH = 2, DFF = 8192;
constexpr int IN_COLS = 13120, NPROJ = 7168, NGATE = 6144;
constexpr float EPS = 1e-6f;
constexpr size_t SZ_WIN = (size_t)NPROJ * 2048 * 2, SZ_WG = (size_t)NGATE * 2048 * 2, SZ_WUQ = (size_t)1536 * 512 * 2, SZ_WUKV = (size_t)2048 * 256 * 2,
                 SZ_WOA = (size_t)2048 * 1024 * 2, SZ_WOC = (size_t)2048 * 512 * 2, SZ_WOUT = (size_t)2048 * 2048 * 2, SZ_WUP = (size_t)8192 * 2048 * 2;
constexpr size_t OFF_WIN = 0, OFF_WG = OFF_WIN + SZ_WIN, OFF_WUQ = OFF_WG + SZ_WG, OFF_WUKV = OFF_WUQ + SZ_WUQ, OFF_WOA = OFF_WUKV + SZ_WUKV, OFF_WOB = OFF_WOA + SZ_WOA,
                 OFF_WOC = OFF_WOB + SZ_WOA, OFF_WOUT = OFF_WOC + SZ_WOC, OFF_WUP = OFF_WOUT + SZ_WOUT, OFF_WDN = OFF_WUP + SZ_WUP, OFF_XN = OFF_WDN + SZ_WUP;
constexpr size_t SZ_T2048B = (size_t)T * 2048 * 2;
constexpr size_t OFF_OA = OFF_XN + SZ_T2048B, OFF_OB = OFF_OA + (size_t)T * 1024 * 2;
constexpr size_t OFF_PA = OFF_OB + (size_t)T * 1024 * 2;
constexpr size_t OFF_CQN = OFF_PA + (size_t)T * 1024 * 4, OFF_CKVN = OFF_CQN + (size_t)T * 512 * 2;
constexpr size_t OFF_BIG = OFF_CKVN + (size_t)T * 256 * 2;
constexpr size_t OFF_PBC = OFF_BIG, OFF_QA = OFF_PBC + (size_t)T * 6144 * 2, OFF_KA = OFF_QA + (size_t)T * 1536 * 2, OFF_KVR = OFF_KA + (size_t)T * 1536 * 2;
constexpr size_t WS_END = OFF_KVR + SZ_T2048B;
constexpr size_t OFF_CTL = WS_END, CTL_BYTES = 16384, OFF_XB = WS_END + CTL_BYTES  , WS_TOTAL = OFF_XB + (size_t)T * 2048 * 2;
static_assert(XCD_BAR_WORDS * 4 <= CTL_BYTES, "ctl");
constexpr size_t OFF_OC3 = OFF_PA, OFF_LSE = OFF_OC3 + (size_t)3 * T * 512 * 2, OFF_OC = OFF_LSE + (size_t)3 * T * 4 * 4;
static_assert(OFF_OC + (size_t)T * 512 * 2 <= OFF_BIG, "OC overlay");
constexpr size_t OFF_SIG = OFF_BIG, OFF_MT = OFF_SIG + (size_t)T * 2048 * 4, OFF_MRG = OFF_MT + (size_t)T * 2048 * 4;
static_assert(OFF_MRG + SZ_T2048B <= WS_END, "merge overlay");
constexpr size_t OFF_H = OFF_BIG;
static_assert(OFF_H + (size_t)T * 8192 * 2 <= WS_END, "H overlay");

struct Args;
typedef const __attribute__((address_space(4))) Args* KArgs;
struct Args {
    const float *x, *attn_norm, *w_in, *b_gate, *q_lat_norm, *w_uq, *kv_lat_norm, *w_ukv, *q_head_norm, *k_head_norm, *gqa_q_norm, *gqa_k_norm, *dil_q_norm, *dil_k_norm,
                *w_oa, *w_ob, *w_oc, *w_out, *mlp_norm, *w_up, *w_down;
    float* out; unsigned char* ws;
};

__device__ __forceinline__ float bf2f(unsigned h) { return __uint_as_float(h << 16); }
__device__ __forceinline__ unsigned pk2(float lo, float hi) { return pg8::cvt_pk_bf16(lo, hi); }
__device__ __forceinline__ float wave_sum(float v) {
#pragma unroll
    for (int o = 1; o < 64; o <<= 1) v += __shfl_xor(v, o);
    return v;
}
struct TrItem { const float* W; bf16_t* WT; int ld, K, nblk, r; };
__device__ __forceinline__ void tr_load(const TrItem& it, float (&v)[32], int lane) {
    const int kb = it.r / it.nblk, nb = it.r - kb * it.nblk; const float* p = it.W + (size_t)(64 * kb + (lane >> 5)) * it.ld + 32 * nb + (lane & 31);
#pragma unroll
    for (int i = 0; i < 32; ++i) v[i] = p[(size_t)(2 * i) * it.ld];
}
__device__ __forceinline__ void tr_store(const TrItem& it, const float (&v)[32], LAS float* scr, int lane) {
    const int kb = it.r / it.nblk, nb = it.r - kb * it.nblk, k0 = 64 * kb, n0 = 32 * nb;
#pragma unroll
    for (int i = 0; i < 32; ++i) scr[(2 * i + (lane >> 5)) * 33 + (lane & 31)] = v[i];
    asm volatile("s_waitcnt lgkmcnt(0)" ::: "memory");
    const int c = lane & 7;
#pragma unroll
    for (int j = 0; j < 4; ++j) { const int n = (lane >> 3) + 8 * j; const LAS float* s = scr + (8 * c) * 33 + n;
        u32x4 o; o.x = pk2(s[0 * 33], s[1 * 33]); o.y = pk2(s[2 * 33], s[3 * 33]); o.z = pk2(s[4 * 33], s[5 * 33]); o.w = pk2(s[6 * 33], s[7 * 33]);
        *(u32x4*)(it.WT + (size_t)(n0 + n) * it.K + k0 + 8 * c) = o; }
    asm volatile("s_waitcnt lgkmcnt(0)" ::: "memory");
}
__device__ __forceinline__ void rms_rows_f32(const float* x, const float* gain, bf16_t* o, bf16_t* xb, int gw, int NGW, int lane) {
    f32x4 g[8];
#pragma unroll
    for (int j = 0; j < 4; ++j) { const f32x4* gp = (const f32x4*)(gain + 8 * (lane + 64 * j)); g[2 * j] = gp[0]; g[2 * j + 1] = gp[1]; }
    f32x4 v[8];
    { const float* xr = x + (size_t)gw * 2048 + 8 * lane;
#pragma unroll
      for (int j = 0; j < 4; ++j) { v[2 * j] = *(const f32x4*)(xr + 512 * j); v[2 * j + 1] = *(const f32x4*)(xr + 512 * j + 4); } }
    for (int m = gw; m < T; m += NGW) {
        const int mn = (m + NGW < T) ? m + NGW : m; f32x4 vn[8];
        { const float* xr = x + (size_t)mn * 2048 + 8 * lane;
#pragma unroll
            for (int j = 0; j < 4; ++j) { vn[2 * j] = *(const f32x4*)(xr + 512 * j); vn[2 * j + 1] = *(const f32x4*)(xr + 512 * j + 4); } }
        float s = 0.f;
#pragma unroll
        for (int k = 0; k < 8; ++k) s += (v[k].x * v[k].x + v[k].y * v[k].y) + (v[k].z * v[k].z + v[k].w * v[k].w);
        const float rs = rsqrtf(wave_sum(s) * (1.f / 2048.f) + EPS);
        u32x4* o16 = (u32x4*)(o + (size_t)m * 2048) + lane; u32x4* x16 = (u32x4*)(xb + (size_t)m * 2048) + lane;
#pragma unroll
        for (int j = 0; j < 4; ++j) { const f32x4 a = v[2 * j], b = v[2 * j + 1], ga = g[2 * j], gb = g[2 * j + 1]; u32x4 w, c;
            w.x = pk2(a.x * rs * ga.x, a.y * rs * ga.y); w.y = pk2(a.z * rs * ga.z, a.w * rs * ga.w); w.z = pk2(b.x * rs * gb.x, b.y * rs * gb.y); w.w = pk2(b.z * rs * gb.z, b.w * rs * gb.w);
            c.x = pk2(a.x, a.y); c.y = pk2(a.z, a.w); c.z = pk2(b.x, b.y); c.w = pk2(b.z, b.w); o16[64 * j] = w; x16[64 * j] = c; }
#pragma unroll
        for (int k = 0; k < 8; ++k) v[k] = vn[k];
    }
}
__device__ __forceinline__ void rms_rows_bf16(const bf16_t* xb, const float* gain, bf16_t* o, int gw, int NGW, int lane) {
    f32x4 g[8];
#pragma unroll
    for (int j = 0; j < 4; ++j) { const f32x4* gp = (const f32x4*)(gain + 8 * (lane + 64 * j)); g[2 * j] = gp[0]; g[2 * j + 1] = gp[1]; }
    u32x4 r[4];
    { const u32x4* xr = (const u32x4*)(xb + (size_t)gw * 2048) + lane;
#pragma unroll
      for (int j = 0; j < 4; ++j) r[j] = xr[64 * j]; }
    for (int m = gw; m < T; m += NGW) {
        const int mn = (m + NGW < T) ? m + NGW : m; u32x4 rn[4];
        { const u32x4* xr = (const u32x4*)(xb + (size_t)mn * 2048) + lane;
#pragma unroll
            for (int j = 0; j < 4; ++j) rn[j] = xr[64 * j]; }
        f32x4 v[8]; float s = 0.f;
#pragma unroll
        for (int j = 0; j < 4; ++j) { v[2 * j].x = bf2f(r[j].x & 0xffffu); v[2 * j].y = bf2f(r[j].x >> 16); v[2 * j].z = bf2f(r[j].y & 0xffffu); v[2 * j].w = bf2f(r[j].y >> 16);
            v[2 * j + 1].x = bf2f(r[j].z & 0xffffu); v[2 * j + 1].y = bf2f(r[j].z >> 16); v[2 * j + 1].z = bf2f(r[j].w & 0xffffu); v[2 * j + 1].w = bf2f(r[j].w >> 16); }
#pragma unroll
        for (int k = 0; k < 8; ++k) s += (v[k].x * v[k].x + v[k].y * v[k].y) + (v[k].z * v[k].z + v[k].w * v[k].w);
        const float rs = rsqrtf(wave_sum(s) * (1.f / 2048.f) + EPS);
        u32x4* o16 = (u32x4*)(o + (size_t)m * 2048) + lane;
#pragma unroll
        for (int j = 0; j < 4; ++j) { const f32x4 a = v[2 * j], b = v[2 * j + 1], ga = g[2 * j], gb = g[2 * j + 1]; u32x4 w;
            w.x = pk2(a.x * rs * ga.x, a.y * rs * ga.y); w.y = pk2(a.z * rs * ga.z, a.w * rs * ga.w); w.z = pk2(b.x * rs * gb.x, b.y * rs * gb.y); w.w = pk2(b.z * rs * gb.z, b.w * rs * gb.w); o16[64 * j] = w; }
#pragma unroll
        for (int j = 0; j < 4; ++j) r[j] = rn[j];
    }
}

__device__ __forceinline__ void phase_p0(KArgs ap, int l, const float* xin, LAS unsigned char* lds, int gw, int NGW, int wave, int lane) {
    asm volatile("" : "+v"(lane));
    LAS float* scr = (LAS float*)(lds + wave * 16384);
    unsigned char* ws = ap->ws;
    const float* w_in = ap->w_in + (size_t)l * 2048 * IN_COLS;
    constexpr int I1 = (2048 / 64) * (832 / 32), I2 = (2048 / 64) * (6144 / 32), I3 = I2, I4 = (512 / 64) * (1536 / 32), I5 = (256 / 64) * (2048 / 32), I6 = (1024 / 64) * (2048 / 32), I7 = I6,
                  I8 = (512 / 64) * (2048 / 32), I9 = (2048 / 64) * (2048 / 32), I10 = (2048 / 64) * (8192 / 32), I11 = (8192 / 64) * (2048 / 32);
    constexpr int NITEMS = I1 + I2 + I3 + I4 + I5 + I6 + I7 + I8 + I9 + I10 + I11;
    auto resolve = [&](int it) -> TrItem {
        int r = it;
        if (r < I1) return TrItem{w_in, (bf16_t*)(ws + OFF_WIN), IN_COLS, 2048, 832 / 32, r}; r -= I1;
        if (r < I2) return TrItem{w_in + 832, (bf16_t*)(ws + OFF_WIN) + (size_t)1024 * 2048, IN_COLS, 2048, 6144 / 32, r}; r -= I2;
        if (r < I3) return TrItem{w_in + 6976, (bf16_t*)(ws + OFF_WG), IN_COLS, 2048, 6144 / 32, r}; r -= I3;
        if (r < I4) return TrItem{ap->w_uq + (size_t)l * 512 * 1536, (bf16_t*)(ws + OFF_WUQ), 1536, 512, 1536 / 32, r}; r -= I4;
        if (r < I5) return TrItem{ap->w_ukv + (size_t)l * 256 * 2048, (bf16_t*)(ws + OFF_WUKV), 2048, 256, 2048 / 32, r}; r -= I5;
        if (r < I6) return TrItem{ap->w_oa + (size_t)l * 1024 * 2048, (bf16_t*)(ws + OFF_WOA), 2048, 1024, 2048 / 32, r}; r -= I6;
        if (r < I7) return TrItem{ap->w_ob + (size_t)l * 1024 * 2048, (bf16_t*)(ws + OFF_WOB), 2048, 1024, 2048 / 32, r}; r -= I7;
        if (r < I8) return TrItem{ap->w_oc + (size_t)l * 512 * 2048, (bf16_t*)(ws + OFF_WOC), 2048, 512, 2048 / 32, r}; r -= I8;
        if (r < I9) return TrItem{ap->w_out + (size_t)l * 2048 * 2048, (bf16_t*)(ws + OFF_WOUT), 2048, 2048, 2048 / 32, r}; r -= I9;
        if (r < I10) return TrItem{ap->w_up + (size_t)l * 2048 * 8192, (bf16_t*)(ws + OFF_WUP), 8192, 2048, 8192 / 32, r}; r -= I10;
        return TrItem{ap->w_down + (size_t)l * 8192 * 2048, (bf16_t*)(ws + OFF_WDN), 2048, 8192, 2048 / 32, r};
    };
    if (gw < NITEMS) {
        int it = gw; TrItem cur = resolve(it); float v[32]; tr_load(cur, v, lane);
        for (;;) {
            const int nit = it + NGW; const bool has = nit < NITEMS; TrItem nxt = cur; float vn[32];
            if (has) { nxt = resolve(nit); tr_load(nxt, vn, lane); }
            tr_store(cur, v, scr, lane);
            if (!has) break;
            cur = nxt; it = nit;
#pragma unroll
            for (int i = 0; i < 32; ++i) v[i] = vn[i];
        }
    }
    { u32x4* z = (u32x4*)((bf16_t*)(ws + OFF_WIN) + (size_t)832 * 2048); const int n16 = 192 * 2048 * 2 / 16;
      for (int i = gw * 64 + lane; i < n16; i += NGW * 64) z[i] = (u32x4){0u, 0u, 0u, 0u}; }
    const float* g = ap->attn_norm + (size_t)l * 2048;
    if (l == 0) rms_rows_f32(xin, g, (bf16_t*)(ws + OFF_XN), (bf16_t*)(ws + OFF_XB), gw, NGW, lane);
    else rms_rows_bf16((const bf16_t*)(ws + OFF_XB), g, (bf16_t*)(ws + OFF_XN), gw, NGW, lane);
}

__device__ __forceinline__ void phase_p2(KArgs ap, int l, int gw, int NGW, int lane) {
    asm volatile("" : "+v"(lane));
    unsigned char* ws = ap->ws;
    const bf16_t* PA = (const bf16_t*)(ws + OFF_PA); bf16_t* CQN = (bf16_t*)(ws + OFF_CQN); bf16_t* CKVN = (bf16_t*)(ws + OFF_CKVN); bf16_t* PBC = (bf16_t*)(ws + OFF_PBC);
    const float* gcq = ap->q_lat_norm + (size_t)l * 512; const float* gckv = ap->kv_lat_norm + (size_t)l * 256;
    const int q = lane & 15;
    f32x4 G[4][2];
    { const float* gp[4] = {ap->gqa_q_norm + l * 128, ap->gqa_k_norm + l * 128, ap->dil_q_norm + l * 128, ap->dil_k_norm + l * 128};
#pragma unroll
      for (int k = 0; k < 4; ++k) { G[k][0] = *(const f32x4*)(gp[k] + 8 * q); G[k][1] = *(const f32x4*)(gp[k] + 8 * q + 4); } }
    const f32x4 gq0 = *(const f32x4*)(gcq + 4 * lane), gq1 = *(const f32x4*)(gcq + 256 + 4 * lane), gkv = *(const f32x4*)(gckv + 4 * lane);
    constexpr float L2A = 13.287712379549449f  , L2P = 18.931568569324174f  ;
    float inv_ax[8], inv_pr[8];
#pragma unroll
    for (int j = 0; j < 8; ++j) { inv_ax[j] = exp2f(-(float)(8 * (q & 3) + j) * (L2A / 32.0f)); inv_pr[j] = exp2f(-(float)(8 * (q & 1) + j) * (L2P / 16.0f)); }
    const bool ax_first = !(q & 4), pr_first = q < 2, pr_on = q < 4;
#define P2_CV(R) (f32x4){bf2f((R).x & 0xffffu), bf2f((R).x >> 16), bf2f((R).y & 0xffffu), bf2f((R).y >> 16)}
#define P2_LOADA(mm, A0, A1, A2) do { const bf16_t* pa_ = PA + (size_t)(mm) * 1024; A0 = *(const u32x2*)(pa_ + 4 * lane); A1 = *(const u32x2*)(pa_ + 256 + 4 * lane); A2 = *(const u32x2*)(pa_ + 512 + 4 * lane); } while (0)
#define P2_LOADW(mm, I0_, N_, W) do { const bf16_t* row_ = PBC + (size_t)(mm) * 6144 + 8 * lane; _Pragma("unroll") for (int k = 0; k < (N_); ++k) W[k] = *(const u32x4*)(row_ + ((I0_) + k) * 512); } while (0)
#define P2_PROC(I0_, N_, W) do { _Pragma("unroll") for (int k = 0; k < (N_); ++k) { const int I = (I0_) + k; const int kind = I < 2 ? 0 : (I == 2 ? 1 : (I < 6 ? 2 : 3)); \
        const u32x4 w_ = W[k]; float x[8] = {bf2f(w_.x & 0xffffu), bf2f(w_.x >> 16), bf2f(w_.y & 0xffffu), bf2f(w_.y >> 16), bf2f(w_.z & 0xffffu), bf2f(w_.z >> 16), bf2f(w_.w & 0xffffu), bf2f(w_.w >> 16)}; \
        float s_ = 0.f; _Pragma("unroll") for (int j = 0; j < 8; ++j) s_ += x[j] * x[j]; \
        s_ += __shfl_xor(s_, 1); s_ += __shfl_xor(s_, 2); s_ += __shfl_xor(s_, 4); s_ += __shfl_xor(s_, 8); \
        const float rs_ = rsqrtf(s_ * (1.f / 128.f) + EPS); const f32x4 ga = G[kind][0], gb = G[kind][1]; \
        float y[8] = {x[0] * rs_ * ga.x, x[1] * rs_ * ga.y, x[2] * rs_ * ga.z, x[3] * rs_ * ga.w, x[4] * rs_ * gb.x, x[5] * rs_ * gb.y, x[6] * rs_ * gb.z, x[7] * rs_ * gb.w}; \
        if (kind < 2) { _Pragma("unroll") for (int j = 0; j < 8; ++j) { const float p_ = __shfl_xor(y[j], 4); y[j] = y[j] * cax[j] + p_ * sax[j]; } } \
        else { _Pragma("unroll") for (int j = 0; j < 8; ++j) { const float p_ = __shfl_xor(y[j], 2); if (pr_on) y[j] = y[j] * cpr[j] + p_ * spr[j]; } } \
        u32x4 o_; o_.x = pk2(y[0], y[1]); o_.y = pk2(y[2], y[3]); o_.z = pk2(y[4], y[5]); o_.w = pk2(y[6], y[7]); \
        if (I != 2 || lane < 32) *(u32x4*)(row + I * 512 + 8 * lane) = o_; } } while (0)
    u32x2 ra0, ra1, ra2; u32x4 w1[5], w2[4];
    P2_LOADA(gw, ra0, ra1, ra2); P2_LOADW(gw, 0, 5, w1);
    int t_tab = -1; float cax[8], sax[8], cpr[8], spr[8];
#pragma unroll
    for (int j = 0; j < 8; ++j) { cax[j] = 1.f; sax[j] = 0.f; cpr[j] = 1.f; spr[j] = 0.f; }
    for (int m = gw; m < T; m += NGW) {
        const int t = m & (SEQ - 1);
        const int mn = (m + NGW < T) ? m + NGW : m;
        bf16_t* row = PBC + (size_t)m * 6144;
        if (t != t_tab) { t_tab = t;
            const float posax = (q & 8) ? (float)(t & 63) : (float)(t >> 6);
#pragma unroll
            for (int j = 0; j < 8; ++j) { const float a = posax * inv_ax[j]; cax[j] = cosf(a); const float sn = sinf(a); sax[j] = ax_first ? -sn : sn;
                const float b = (float)t * inv_pr[j]; cpr[j] = cosf(b); const float sp = sinf(b); spr[j] = pr_first ? -sp : sp; } }
        __builtin_amdgcn_sched_barrier(0);
        P2_LOADW(m, 5, 4, w2);
        __builtin_amdgcn_sched_barrier(0);
        { const f32x4 v0 = P2_CV(ra0), v1 = P2_CV(ra1), v2 = P2_CV(ra2);
          float s0 = (v0.x * v0.x + v0.y * v0.y) + (v0.z * v0.z + v0.w * v0.w) + (v1.x * v1.x + v1.y * v1.y) + (v1.z * v1.z + v1.w * v1.w);
          float s1 = (v2.x * v2.x + v2.y * v2.y) + (v2.z * v2.z + v2.w * v2.w);
#pragma unroll
          for (int o = 1; o < 64; o <<= 1) { s0 += __shfl_xor(s0, o); s1 += __shfl_xor(s1, o); }
          { const float rs = rsqrtf(s0 * (1.f / 512.f) + EPS);
            u32x2 qq; qq.x = pk2(v0.x * rs * gq0.x, v0.y * rs * gq0.y); qq.y = pk2(v0.z * rs * gq0.z, v0.w * rs * gq0.w); *(u32x2*)(CQN + (size_t)m * 512 + 4 * lane) = qq;
            qq.x = pk2(v1.x * rs * gq1.x, v1.y * rs * gq1.y); qq.y = pk2(v1.z * rs * gq1.z, v1.w * rs * gq1.w); *(u32x2*)(CQN + (size_t)m * 512 + 256 + 4 * lane) = qq; }
          { const float rs = rsqrtf(s1 * (1.f / 256.f) + EPS);
            u32x2 qq; qq.x = pk2(v2.x * rs * gkv.x, v2.y * rs * gkv.y); qq.y = pk2(v2.z * rs * gkv.z, v2.w * rs * gkv.w); *(u32x2*)(CKVN + (size_t)m * 256 + 4 * lane) = qq; } }
        __builtin_amdgcn_sched_barrier(0);
        P2_LOADA(mn, ra0, ra1, ra2);
        __builtin_amdgcn_sched_barrier(0);
        P2_PROC(0, 5, w1);
        __builtin_amdgcn_sched_barrier(0);
        P2_LOADW(mn, 0, 5, w1);
        __builtin_amdgcn_sched_barrier(0);
        P2_PROC(5, 4, w2);
    }
#undef P2_LOADA
#undef P2_CV
#undef P2_LOADW
#undef P2_PROC
}

__device__ __forceinline__ void phase_p3b(KArgs ap, int l, int gw, int NGW, int lane) {
    asm volatile("" : "+v"(lane));
    unsigned char* ws = ap->ws;
    const bf16_t* PA = (const bf16_t*)(ws + OFF_PA); bf16_t* QA = (bf16_t*)(ws + OFF_QA); bf16_t* KA = (bf16_t*)(ws + OFF_KA); const bf16_t* KVR = (const bf16_t*)(ws + OFF_KVR);
    const float* gq = ap->q_head_norm + (size_t)l * 192; const float* gk = ap->k_head_norm + (size_t)l * 192;
    const float gq0 = gq[2 * lane], gq1 = gq[2 * lane + 1], gq2 = gq[128 + lane], gk0 = gk[2 * lane], gk1 = gk[2 * lane + 1], gk2 = gk[128 + lane];
    constexpr float L2A = 13.287712379549449f;
    const float inv = exp2f(-(float)(lane & 31) * (L2A / 32.0f));
    const bool first = lane < 32;
    unsigned qw[8], kw[8]; unsigned short qr[8]; float kpe;
#define P3B_LOAD(mm, QW, QR, KW, KPE) do { const bf16_t* q_ = QA + (size_t)(mm) * 1536; const bf16_t* kv_ = KVR + (size_t)(mm) * 2048; KPE = bf2f(PA[(size_t)(mm) * 1024 + 768 + lane]); \
        _Pragma("unroll") for (int h = 0; h < 8; ++h) { QW[h] = *((const unsigned*)(q_ + h * 192) + lane); QR[h] = q_[h * 192 + 128 + lane]; KW[h] = *((const unsigned*)(kv_ + h * 256) + lane); } } while (0)
    P3B_LOAD(gw, qw, qr, kw, kpe);
    for (int m = gw; m < T; m += NGW) {
        const int t = m & (SEQ - 1);
        bf16_t* qrow = QA + (size_t)m * 1536; bf16_t* krow = KA + (size_t)m * 1536;
        const int mn = (m + NGW < T) ? m + NGW : m;
        unsigned qwn[8], kwn[8]; unsigned short qrn[8]; float kpen;
        P3B_LOAD(mn, qwn, qrn, kwn, kpen);
        float ss[16];
#pragma unroll
        for (int h = 0; h < 8; ++h) { const float a0 = bf2f(qw[h] & 0xffffu), a1 = bf2f(qw[h] >> 16), a2 = bf2f(qr[h]); ss[h] = a0 * a0 + a1 * a1 + a2 * a2;
            const float b0 = bf2f(kw[h] & 0xffffu), b1 = bf2f(kw[h] >> 16); ss[8 + h] = b0 * b0 + b1 * b1 + kpe * kpe; }
#pragma unroll
        for (int o = 1; o < 64; o <<= 1) {
#pragma unroll
            for (int k = 0; k < 16; ++k) ss[k] += __shfl_xor(ss[k], o); }
        const float ang = (float)t * inv; const float c = cosf(ang); float s = sinf(ang); if (first) s = -s;
#pragma unroll
        for (int h = 0; h < 8; ++h) {
            { const float x0 = bf2f(qw[h] & 0xffffu), x1 = bf2f(qw[h] >> 16), x2 = bf2f(qr[h]);
              const float rs = rsqrtf(ss[h] * (1.f / 192.f) + EPS);
              float y2 = x2 * rs * gq2; const float p2 = __shfl_xor(y2, 32); y2 = y2 * c + p2 * s;
              *((unsigned*)(qrow + h * 192) + lane) = pk2(x0 * rs * gq0, x1 * rs * gq1); qrow[h * 192 + 128 + lane] = (bf16_t)(pk2(y2, 0.f) & 0xffffu); }
            { const float x0 = bf2f(kw[h] & 0xffffu), x1 = bf2f(kw[h] >> 16), x2 = kpe;
              const float rs = rsqrtf(ss[8 + h] * (1.f / 192.f) + EPS);
              float y2 = x2 * rs * gk2; const float p2 = __shfl_xor(y2, 32); y2 = y2 * c + p2 * s;
              *((unsigned*)(krow + h * 192) + lane) = pk2(x0 * rs * gk0, x1 * rs * gk1); krow[h * 192 + 128 + lane] = (bf16_t)(pk2(y2, 0.f) & 0xffffu); }
        }
#pragma unroll
        for (int h = 0; h < 8; ++h) { qw[h] = qwn[h]; qr[h] = qrn[h]; kw[h] = kwn[h]; }
        kpe = kpen;
    }
#undef P3B_LOAD
}

__device__ __forceinline__ void phase_p4(KArgs ap, unsigned char* lds_g, int G, int bid) {
    unsigned char* ws = ap->ws;
    bf16_t* PBC = (bf16_t*)(ws + OFF_PBC); bf16_t* QA = (bf16_t*)(ws + OFF_QA); bf16_t* KA = (bf16_t*)(ws + OFF_KA); bf16_t* KVR = (bf16_t*)(ws + OFF_KVR);
    bf16_t* OA = (bf16_t*)(ws + OFF_OA); bf16_t* OB = (bf16_t*)(ws + OFF_OB); bf16_t* OC3 = (bf16_t*)(ws + OFF_OC3); float* LSE = (float*)(ws + OFF_LSE);
    for (int i = bid; i < 2048; i += G) {
        att::Unit u;
        if (i < 512) {
            const int xs_ = i & 255, bh_ = (i >> 8) * 32 + (xs_ & 7) * 4 + (xs_ >> 6), b = bh_ >> 3, h = bh_ & 7, qb = (xs_ >> 3) & 7; const size_t tb = (size_t)b * SEQ;
            u.Q = QA + tb * 1536 + h * 192; u.K = KA + tb * 1536 + h * 192; u.V = KVR + tb * 2048 + h * 256 + 128; u.O = OA + tb * 1024 + h * 128; u.LSE = nullptr;
            u.ldq = 1536; u.ldk = 1536; u.ldv = 2048; u.ldo = 1024; u.ldlse = 0; u.q0 = qb * 256; u.L = SEQ; u.kt0 = 0; u.kt1 = 32; u.R = 1 << 30;
#ifdef ATT_PIPE192
            att::attn_unit_pipe<192>(u, (char*)lds_g);
#else
            att::attn_unit<192>(u, (char*)lds_g);
#endif
        } else {
            if (i < 1024) {
                const int j = i - 512, xs_ = j & 255, bh_ = (j >> 8) * 32 + (xs_ & 7) * 4 + (xs_ >> 6), b = bh_ >> 3, h = bh_ & 7, qb = (xs_ >> 3) & 7, kvh = h >> 2; const size_t tb = (size_t)b * SEQ;
                u.Q = PBC + tb * 6144 + h * 128; u.K = PBC + tb * 6144 + 1024 + kvh * 128; u.V = PBC + tb * 6144 + 1280 + kvh * 128; u.O = OB + tb * 1024 + h * 128; u.LSE = nullptr;
                u.ldq = 6144; u.ldk = 6144; u.ldv = 6144; u.ldo = 1024; u.ldlse = 0; u.q0 = qb * 256; u.L = SEQ; u.kt0 = 0; u.kt1 = 32; u.R = 1 << 30;
            } else {
                int g, b, h, r, qb, dil, L;
                if (i < 1280) { const int j = i - 1024, bh_ = (j & 7) * 4 + (j >> 6); g = 0; b = bh_ >> 2; h = bh_ & 3; r = 0; qb = (j >> 3) & 7; dil = 1; L = 2048; }
                else if (i < 1536) { const int j = i - 1280; g = 1; b = j >> 5; h = (j >> 3) & 3; r = (j >> 1) & 3; qb = j & 1; dil = 4; L = 512; }
                else { const int j = i - 1536; g = 2; b = j >> 6; h = (j >> 4) & 3; r = j & 15; qb = 0; dil = 16; L = 128; }
                const size_t tok = (size_t)b * SEQ + r; const int hd = g * 4 + h;
                u.Q = PBC + tok * 6144 + 1536 + hd * 128; u.K = PBC + tok * 6144 + 3072 + hd * 128; u.V = PBC + tok * 6144 + 4608 + hd * 128;
                u.O = OC3 + (size_t)g * T * 512 + tok * 512 + h * 128; u.LSE = LSE + (size_t)g * T * 4 + tok * 4 + h;
                u.ldq = u.ldk = u.ldv = dil * 6144; u.ldo = dil * 512; u.ldlse = dil * 4; u.q0 = qb * 256; u.L = L; u.R = 64;
                const int klo = u.q0 - 64 < 0 ? 0 : u.q0 - 64, khi = u.q0 + 320 > L ? L : u.q0 + 320;
                u.kt0 = klo >> 6; u.kt1 = khi >> 6;
                if ((u.kt1 - u.kt0) & 1) { if (u.kt0 > 0) --u.kt0; else ++u.kt1; }
            }
#ifdef ATT_PIPE128
            att::attn_unit_pipe<128>(u, (char*)lds_g);
#else
            att::attn_unit<128>(u, (char*)lds_g);
#endif
        }
    }
}

__device__ __forceinline__ void phase_p4b(KArgs ap, int gtid, int NGT) {
    asm volatile("" : "+v"(gtid));
    unsigned char* ws = ap->ws;
    const bf16_t* OC3 = (const bf16_t*)(ws + OFF_OC3); const float* LSE = (const float*)(ws + OFF_LSE); bf16_t* OC = (bf16_t*)(ws + OFF_OC);
#define P4B_LOAD(ii, L0, L1, L2, V0, V1, V2) do { const int m_ = (ii) >> 6, c_ = (ii) & 63, h_ = c_ >> 4; \
        L0 = LSE[(size_t)m_ * 4 + h_]; L1 = LSE[(size_t)T * 4 + (size_t)m_ * 4 + h_]; L2 = LSE[(size_t)2 * T * 4 + (size_t)m_ * 4 + h_]; \
        V0 = *(const u32x4*)(OC3 + (size_t)m_ * 512 + c_ * 8); V1 = *(const u32x4*)(OC3 + (size_t)T * 512 + (size_t)m_ * 512 + c_ * 8); V2 = *(const u32x4*)(OC3 + (size_t)2 * T * 512 + (size_t)m_ * 512 + c_ * 8); } while (0)
    float l0, l1, l2; u32x4 v0, v1, v2;
    if (gtid < T * 64) P4B_LOAD(gtid, l0, l1, l2, v0, v1, v2);
    for (int i = gtid; i < T * 64; i += NGT) {
        const int in = (i + NGT < T * 64) ? i + NGT : i;
        float n0, n1, n2; u32x4 w0, w1_, w2_;
        P4B_LOAD(in, n0, n1, n2, w0, w1_, w2_);
        const int m = i >> 6, c = i & 63;
        const float mx = fmaxf(l0, fmaxf(l1, l2)); float a0 = __expf(l0 - mx), a1 = __expf(l1 - mx), a2 = __expf(l2 - mx); const float inv = 1.f / (a0 + a1 + a2); a0 *= inv; a1 *= inv; a2 *= inv;
        u32x4 o;
#pragma unroll
        for (int e = 0; e < 4; ++e) { const float lo = a0 * bf2f(v0[e] & 0xffffu) + a1 * bf2f(v1[e] & 0xffffu) + a2 * bf2f(v2[e] & 0xffffu);
            const float hi = a0 * bf2f(v0[e] >> 16) + a1 * bf2f(v1[e] >> 16) + a2 * bf2f(v2[e] >> 16); o[e] = pk2(lo, hi); }
        *(u32x4*)(OC + (size_t)m * 512 + c * 8) = o;
        l0 = n0; l1 = n1; l2 = n2; v0 = w0; v1 = w1_; v2 = w2_;
    }
#undef P4B_LOAD
}

#ifndef GEMM_ALIGN
#define GEMM_ALIGN true
#endif
#ifndef GEMM_SP2
#define GEMM_SP2 true
#endif
template <class Epi>
__device__ __forceinline__ void run_gemm(LAS unsigned char* lds, const bf16_t* A, const bf16_t* Bt, int N, int K, const Epi& E, int G, int bid) {
    pg8::Gemm g{A, Bt, T, N, K}; pg8::StaticOrder S; S.init(T, N, G, bid);
    pg8::gemm_phase<Epi, pg8::StaticOrder, GEMM_ALIGN, GEMM_SP2>(lds, g, S, E);
}

#define KARGS KArgs ap = (KArgs)__builtin_amdgcn_kernarg_segment_ptr(); asm volatile("" : "+s"(ap)); unsigned char* ws = ap->ws; int bid = blockIdx.x; asm volatile("" : "+s"(bid)); \
    const int G = gridDim.x; (void)ws; (void)bid; (void)G
#define WAVEIDS int tid = threadIdx.x; asm volatile("" : "+v"(tid)); const int lane = tid & 63, wave = __builtin_amdgcn_readfirstlane(tid >> 6); const int gw = bid * NWAVES + wave, NGW = G * NWAVES; (void)lane; (void)gw; (void)NGW
__global__ void __launch_bounds__(NTHR, 2) fwd_kernel(Args a_unused) {
    extern __shared__ __attribute__((aligned(16))) unsigned char lds_g[];
    cg::grid_group grid = cg::this_grid();
    LAS unsigned char* lds = (LAS unsigned char*)lds_g;
    volatile LAS unsigned* bst = (volatile LAS unsigned*)(lds + 131072);
    if (threadIdx.x < 2) bst[threadIdx.x] = 0u;
    __syncthreads();
    { KARGS; (void)xcd_barrier_post((unsigned*)(ws + OFF_CTL), bst); }
#define GRID_BAR() do { KARGS; XcdBarrier b_; b_.bar = (unsigned*)(ws + OFF_CTL); b_.x = xb_xcc_id(); b_.st = bst; xcd_barrier(b_); } while (0)
#pragma unroll 1
    for (int l = 0; l < DEPTH; ++l) {
#ifndef NO_P0
        { KARGS; WAVEIDS; phase_p0(ap, l, (l == 0) ? ap->x : ap->out, lds, gw, NGW, wave, lane); }
#ifdef PROBE_P0X2
        if (l == 0) grid.sync(); else GRID_BAR();
        { KARGS; WAVEIDS; phase_p0(ap, l, (l == 0) ? ap->x : ap->out, lds, gw, NGW, wave, lane); }
#endif
#ifdef PROBE_SYNCS
#pragma unroll 1
        for (int q = 0; q < 20; ++q) GRID_BAR();
#endif
#endif
        GRID_BAR();
#ifndef NO_P1
        { KARGS; pg8::EpiProj E{(bf16_t*)(ws + OFF_PA), 1024, 4, (bf16_t*)(ws + OFF_PBC), 6144}; run_gemm(lds, (const bf16_t*)(ws + OFF_XN), (const bf16_t*)(ws + OFF_WIN), NPROJ, 2048, E, G, bid); }
#endif
        GRID_BAR();
#ifndef NO_P2
        { KARGS; WAVEIDS; phase_p2(ap, l, gw, NGW, lane); }
#endif
        GRID_BAR();
#ifndef NO_P3
        { KARGS; pg8::EpiBf16<0> E{(bf16_t*)(ws + OFF_QA), 1536}; run_gemm(lds, (const bf16_t*)(ws + OFF_CQN), (const bf16_t*)(ws + OFF_WUQ), 1536, 512, E, G, bid); }
        { KARGS; pg8::EpiBf16<0> E{(bf16_t*)(ws + OFF_KVR), 2048}; run_gemm(lds, (const bf16_t*)(ws + OFF_CKVN), (const bf16_t*)(ws + OFF_WUKV), 2048, 256, E, G, bid); }
#ifdef PROBE_P3X2
        { KARGS; pg8::EpiBf16<0> E{(bf16_t*)(ws + OFF_QA), 1536}; run_gemm(lds, (const bf16_t*)(ws + OFF_CQN), (const bf16_t*)(ws + OFF_WUQ), 1536, 512, E, G, bid); }
        { KARGS; pg8::EpiBf16<0> E{(bf16_t*)(ws + OFF_KVR), 2048}; run_gemm(lds, (const bf16_t*)(ws + OFF_CKVN), (const bf16_t*)(ws + OFF_WUKV), 2048, 256, E, G, bid); }
#endif
#endif
        GRID_BAR();
#ifndef NO_P3B
        { KARGS; WAVEIDS; phase_p3b(ap, l, gw, NGW, lane); }
#endif
        GRID_BAR();
#ifndef NO_P4
        { KARGS; phase_p4(ap, lds_g, G, bid); }
#ifdef PROBE_P4X2
        GRID_BAR();
        { KARGS; phase_p4(ap, lds_g, G, bid); }
#endif
#endif
        GRID_BAR();
#ifndef NO_P4B
        { KARGS; int tid = threadIdx.x; phase_p4b(ap, bid * NTHR + tid, G * NTHR); }
#endif
        GRID_BAR();
#ifndef NO_P5
#ifdef PROBE_P5X2
#pragma unroll 1
        for (int rep = 0; rep < 2; ++rep)
#endif
#pragma unroll 1
        for (int i = 0; i < 3; ++i) {
            { KARGS; pg8::EpiSig E{(u32x4*)(ws + OFF_SIG), ap->b_gate + (size_t)l * NGATE + i * 2048, 8};
              run_gemm(lds, (const bf16_t*)(ws + OFF_XN), (const bf16_t*)(ws + OFF_WG) + (size_t)i * 2048 * 2048, 2048, 2048, E, G, bid); }
#ifdef PROBE_GATEX2
            { KARGS; pg8::EpiSig E{(u32x4*)(ws + OFF_SIG), ap->b_gate + (size_t)l * NGATE + i * 2048, 8};
              run_gemm(lds, (const bf16_t*)(ws + OFF_XN), (const bf16_t*)(ws + OFF_WG) + (size_t)i * 2048 * 2048, 2048, 2048, E, G, bid); }
#endif
            { KARGS; const bf16_t* A = (const bf16_t*)(ws + (i == 0 ? OFF_OA : (i == 1 ? OFF_OB : OFF_OC)));
              const bf16_t* Bt = (const bf16_t*)(ws + (i == 0 ? OFF_WOA : (i == 1 ? OFF_WOB : OFF_WOC)));
              pg8::EpiGate E{(const u32x4*)(ws + OFF_SIG), (u32x4*)(ws + OFF_MT), (bf16_t*)(ws + OFF_MRG), 2048, 8, i};
              run_gemm(lds, A, Bt, 2048, i == 2 ? 512 : 1024, E, G, bid); }
        }
#endif
        GRID_BAR();
#ifndef NO_P6
        { KARGS; pg8::EpiResidB<false> E{(const bf16_t*)(ws + OFF_XB), (bf16_t*)(ws + OFF_XB), nullptr, 2048}; run_gemm(lds, (const bf16_t*)(ws + OFF_MRG), (const bf16_t*)(ws + OFF_WOUT), 2048, 2048, E, G, bid); }
#endif
        GRID_BAR();
        { KARGS; WAVEIDS; const float* g = ap->mlp_norm + (size_t)l * 2048; const float* xo = ap->out;
          rms_rows_bf16((const bf16_t*)(ws + OFF_XB), g, (bf16_t*)(ws + OFF_XN), gw, NGW, lane); (void)xo; }
        GRID_BAR();
#ifndef NO_P8
        { KARGS; pg8::EpiBf16<1> E{(bf16_t*)(ws + OFF_H), 8192}; run_gemm(lds, (const bf16_t*)(ws + OFF_XN), (const bf16_t*)(ws + OFF_WUP), 8192, 2048, E, G, bid); }
#ifdef PROBE_P8X2
        GRID_BAR();
        { KARGS; pg8::EpiBf16<1> E{(bf16_t*)(ws + OFF_H), 8192}; run_gemm(lds, (const bf16_t*)(ws + OFF_XN), (const bf16_t*)(ws + OFF_WUP), 8192, 2048, E, G, bid); }
#endif
#endif
        GRID_BAR();
#ifndef NO_P9
        if (l + 1 < DEPTH) { KARGS; pg8::EpiResidB<false> E{(const bf16_t*)(ws + OFF_XB), (bf16_t*)(ws + OFF_XB), nullptr, 2048}; run_gemm(lds, (const bf16_t*)(ws + OFF_H), (const bf16_t*)(ws + OFF_WDN), 2048, 8192, E, G, bid); }
        else { KARGS; pg8::EpiResidB<true> E{(const bf16_t*)(ws + OFF_XB), nullptr, ap->out, 2048}; run_gemm(lds, (const bf16_t*)(ws + OFF_H), (const bf16_t*)(ws + OFF_WDN), 2048, 8192, E, G, bid); }
#endif
        if (l + 1 < DEPTH) GRID_BAR();
    }
}

extern "C" void kernel_launch(void* const* d_in, const int* in_sizes, int n_in, void* d_out, int out_size, void* d_ws, size_t ws_size, hipStream_t stream) {
    static int grid = 0;
    if (grid == 0) {
        if (n_in != 21 || in_sizes[0] != T * DM || out_size != T * DM || ws_size < WS_TOTAL) {
            fprintf(stderr, "kernel_launch: unexpected shapes: n_in %d in0 %d out %d ws %zu (need %zu)\n", n_in, n_in > 0 ? in_sizes[0] : -1, out_size, ws_size, (size_t)WS_TOTAL); grid = -1; return; }
        int dev = 0, cus = 0, per_cu = 0;
        if (hipGetDevice(&dev) != hipSuccess || hipDeviceGetAttribute(&cus, hipDeviceAttributeMultiprocessorCount, dev) != hipSuccess) { grid = -1; return; }
        if (hipFuncSetAttribute((const void*)fwd_kernel, hipFuncAttributeMaxDynamicSharedMemorySize, LDS_BYTES) != hipSuccess) { fprintf(stderr, "kernel_launch: hipFuncSetAttribute failed\n"); grid = -1; return; }
        if (hipOccupancyMaxActiveBlocksPerMultiprocessor(&per_cu, (const void*)fwd_kernel, NTHR, LDS_BYTES) != hipSuccess || per_cu < 1) { fprintf(stderr, "kernel_launch: occupancy query says %d\n", per_cu); per_cu = 1; }
        (void)hipGetLastError();
        grid = cus;
    }
    if (grid < 0) return;
    if (hipMemsetAsync((char*)d_ws + OFF_CTL, 0, CTL_BYTES, stream) != hipSuccess) { fprintf(stderr, "kernel_launch: memset failed\n"); return; }
    Args a{};
    const float** pp = (const float**)&a;
    for (int i = 0; i < 21; ++i) pp[i] = (const float*)d_in[i];
    a.out = (float*)d_out; a.ws = (unsigned char*)d_ws;
    void* args[] = {&a};
    hipError_t e = hipLaunchCooperativeKernel((const void*)fwd_kernel, dim3(grid), dim3(NTHR), args, LDS_BYTES, stream);
    if (e != hipSuccess) fprintf(stderr, "kernel_launch: cooperative launch failed: %s (grid %d)\n", hipGetErrorString(e), grid);
}
```
